# Optimizing an MI355X kernel written in HIP

```python
import jax, jax.numpy as jnp
from jax import lax
import numpy as np

D_MODEL = 2048
BATCH = 8
SEQ = 4096
DEPTH = 1
DEC_BATCH = 8
DEC_SEQ = 16
PAST_LEN = 2048

CHUNK = 64
HEAD_DIM = 64
N_HEADS_A = 16
N_HEADS_B = 16
N_KV_B = 2
GQA_R = N_HEADS_B // N_KV_B
D_A = N_HEADS_A * HEAD_DIM
D_B = N_HEADS_B * HEAD_DIM
D_KV_B = N_KV_B * HEAD_DIM
D_IN = 3 * D_A + D_B + 2 * D_KV_B
A_PREV_CHUNKS = 8
A_REACH = A_PREV_CHUNKS * CHUNK
REL_CLIP = 128
B_WINDOW = 128
B_PREV_CHUNKS = B_WINDOW // CHUNK
ROPE_THETA = 500000.0
ROPE_DIM = HEAD_DIM // 4
D_FF = -(-8 * D_MODEL // (3 * 256)) * 256
NEG_INF = -1e30
EPS = 1e-6

kernel_name = 'hymba_chunk_band_swa_sink_encoder_step'


def rmsnorm(x, g):
    xf = x.astype(jnp.float32)
    y = xf * lax.rsqrt(jnp.mean(xf * xf, axis=-1, keepdims=True) + EPS)
    return (y * g.astype(jnp.float32)).astype(x.dtype)


def rope_partial(x, pos):
    half = ROPE_DIM // 2
    inv_freq = ROPE_THETA ** (-jnp.arange(half, dtype=jnp.float32) * 2.0 / ROPE_DIM)
    ang = pos.astype(jnp.float32)[:, None] * inv_freq[None, :]
    cos = jnp.cos(ang)[:, None, :]
    sin = jnp.sin(ang)[:, None, :]
    xf = x.astype(jnp.float32)
    x1 = xf[..., :half]
    x2 = xf[..., half:ROPE_DIM]
    out = jnp.concatenate([x1 * cos - x2 * sin, x2 * cos + x1 * sin, xf[..., ROPE_DIM:]], axis=-1)
    return out.astype(x.dtype)


def split_proj(p):
    b, s, _ = p.shape
    cuts = [D_A, 2 * D_A, 3 * D_A, 3 * D_A + D_B, 3 * D_A + D_B + D_KV_B]
    qa, ka, va, qb, kb, vb = jnp.split(p, cuts, axis=-1)
    return (qa.reshape(b, s, N_HEADS_A, HEAD_DIM), ka.reshape(b, s, N_HEADS_A, HEAD_DIM),
            va.reshape(b, s, N_HEADS_A, HEAD_DIM), qb.reshape(b, s, N_HEADS_B, HEAD_DIM),
            kb.reshape(b, s, N_KV_B, HEAD_DIM), vb.reshape(b, s, N_KV_B, HEAD_DIM))


def band_gather(t, n_prev):
    b, s, h, d = t.shape
    nc = s // CHUNK
    tp = jnp.pad(t.reshape(b, nc, CHUNK, h, d), ((0, 0), (n_prev, 0), (0, 0), (0, 0), (0, 0)))
    idx = jnp.arange(nc)[:, None] + jnp.arange(n_prev + 1)[None, :]
    return tp[:, idx].reshape(b, nc, (n_prev + 1) * CHUNK, h, d)


def band_valid(nc, n_prev):
    src = jnp.arange(nc)[:, None] - n_prev + jnp.arange(n_prev + 1)[None, :]
    return jnp.repeat(src >= 0, CHUNK, axis=1)


def rel_bias(table, qpos, kpos):
    rel = jnp.clip(qpos[:, None] - kpos[None, :], -REL_CLIP, REL_CLIP) + REL_CLIP
    return table.astype(jnp.float32)[:, rel][:, None]


def band_attend(q, k, v, valid, bias=None, sink=None):
    s = jnp.einsum('bgqhrd,bgkhd->bghrqk', q, k, preferred_element_type=jnp.float32) * (HEAD_DIM ** -0.5)
    if bias is not None:
        s = s + bias
    s = jnp.where(valid[None, :, None, None, None, :], s, NEG_INF)
    m = jnp.max(s, axis=-1, keepdims=True)
    if sink is not None:
        sk = sink.astype(jnp.float32)[None, None, :, :, None, None]
        m = jnp.maximum(m, sk)
        p = jnp.exp(s - m)
        denom = jnp.sum(p, axis=-1, keepdims=True) + jnp.exp(sk - m)
    else:
        p = jnp.exp(s - m)
        denom = jnp.sum(p, axis=-1, keepdims=True)
    w = (p / denom).astype(v.dtype)
    o = jnp.einsum('bghrqk,bgkhd->bgqhrd', w, v)
    b, g, nq = o.shape[:3]
    return o.reshape(b, g * nq, -1)


def merge_and_ffn(x, oa, ob, norm_grp_a, norm_grp_b, w_out, norm_ffn, w_gate, w_up, w_down):
    o = jnp.concatenate([rmsnorm(oa, norm_grp_a), rmsnorm(ob, norm_grp_b)], axis=-1)
    x = x + o @ w_out
    h = rmsnorm(x, norm_ffn)
    return x + (jax.nn.silu(h @ w_gate) * (h @ w_up)) @ w_down


def prompt_layer(x, w_in, norm_mix, rel_table, sinks, norm_grp_a, norm_grp_b, w_out,
                 norm_ffn, w_gate, w_up, w_down):
    b, s, _ = x.shape
    nc = s // CHUNK
    pos = jnp.arange(s, dtype=jnp.int32)
    qa, ka, va, qb, kb, vb = split_proj(rmsnorm(x, norm_mix) @ w_in)
    qb = rope_partial(qb, pos)
    kb = rope_partial(kb, pos)
    bias = rel_bias(rel_table, jnp.arange(CHUNK),
                    jnp.arange((A_PREV_CHUNKS + 1) * CHUNK) - A_PREV_CHUNKS * CHUNK)
    oa = band_attend(qa.reshape(b, nc, CHUNK, N_HEADS_A, 1, HEAD_DIM),
                     band_gather(ka, A_PREV_CHUNKS), band_gather(va, A_PREV_CHUNKS),
                     band_valid(nc, A_PREV_CHUNKS), bias=bias)
    ob = band_attend(qb.reshape(b, nc, CHUNK, N_KV_B, GQA_R, HEAD_DIM),
                     band_gather(kb, B_PREV_CHUNKS), band_gather(vb, B_PREV_CHUNKS),
                     band_valid(nc, B_PREV_CHUNKS), sink=sinks.reshape(N_KV_B, GQA_R))
    y = merge_and_ffn(x, oa, ob, norm_grp_a, norm_grp_b, w_out, norm_ffn, w_gate, w_up, w_down)
    keep_a = min(A_REACH, s)
    keep_b = min(B_WINDOW, s)
    return y, ka[:, s - keep_a:], va[:, s - keep_a:], kb[:, s - keep_b:], vb[:, s - keep_b:]


def sample_layer(x, ck_a, cv_a, ck_b, cv_b, w_in, norm_mix, rel_table, sinks, norm_grp_a,
                 norm_grp_b, w_out, norm_ffn, w_gate, w_up, w_down):
    b, s, _ = x.shape
    pos = PAST_LEN + jnp.arange(s, dtype=jnp.int32)
    qa, ka, va, qb, kb, vb = split_proj(rmsnorm(x, norm_mix) @ w_in)
    qb = rope_partial(qb, pos)
    kb = rope_partial(kb, pos)
    keep_a = ck_a.shape[1]
    keep_b = ck_b.shape[1]
    bias = rel_bias(rel_table, jnp.arange(s),
                    jnp.concatenate([jnp.arange(keep_a) - keep_a, jnp.arange(s)]))
    oa = band_attend(qa.reshape(b, 1, s, N_HEADS_A, 1, HEAD_DIM),
                     jnp.concatenate([ck_a, ka], axis=1)[:, None],
                     jnp.concatenate([cv_a, va], axis=1)[:, None],
                     jnp.ones((1, keep_a + s), dtype=bool), bias=bias)
    ob = band_attend(qb.reshape(b, 1, s, N_KV_B, GQA_R, HEAD_DIM),
                     jnp.concatenate([ck_b, kb], axis=1)[:, None],
                     jnp.concatenate([cv_b, vb], axis=1)[:, None],
                     jnp.ones((1, keep_b + s), dtype=bool), sink=sinks.reshape(N_KV_B, GQA_R))
    y = merge_and_ffn(x, oa, ob, norm_grp_a, norm_grp_b, w_out, norm_ffn, w_gate, w_up, w_down)
    return y, ka, va, kb, vb


def setup_inputs(seed: int = 0) -> dict:
    key = jax.random.key(seed)
    ks = jax.random.split(key, 20)
    f32 = jnp.float32
    keep_a = min(A_REACH, PAST_LEN)
    keep_b = min(B_WINDOW, PAST_LEN)

    def nrm(k, shape, scale):
        return jax.random.normal(k, shape, f32) * scale

    return {
        'x_prompt': nrm(ks[0], (BATCH, SEQ, D_MODEL), 1.0),
        'x_sample': nrm(ks[1], (DEC_BATCH, DEC_SEQ, D_MODEL), 1.0),
        'cache_a_k': nrm(ks[2], (DEPTH, DEC_BATCH, keep_a, N_HEADS_A, HEAD_DIM), 1.0),
        'cache_a_v': nrm(ks[3], (DEPTH, DEC_BATCH, keep_a, N_HEADS_A, HEAD_DIM), 1.0),
        'cache_b_k': nrm(ks[4], (DEPTH, DEC_BATCH, keep_b, N_KV_B, HEAD_DIM), 1.0),
        'cache_b_v': nrm(ks[5], (DEPTH, DEC_BATCH, keep_b, N_KV_B, HEAD_DIM), 1.0),
        'w_in': nrm(ks[6], (DEPTH, D_MODEL, D_IN), D_MODEL ** -0.5),
        'norm_mix': 1.0 + nrm(ks[7], (DEPTH, D_MODEL), 0.05),
        'rel_table': nrm(ks[8], (DEPTH, N_HEADS_A, 2 * REL_CLIP + 1), 0.1),
        'sinks': nrm(ks[9], (DEPTH, N_HEADS_B), 0.5),
        'norm_grp_a': 1.0 + nrm(ks[10], (DEPTH, D_A), 0.05),
        'norm_grp_b': 1.0 + nrm(ks[11], (DEPTH, D_B), 0.05),
        'w_out': nrm(ks[12], (DEPTH, D_A + D_B, D_MODEL), (D_A + D_B) ** -0.5),
        'norm_ffn': 1.0 + nrm(ks[13], (DEPTH, D_MODEL), 0.05),
        'w_gate': nrm(ks[14], (DEPTH, D_MODEL, D_FF), D_MODEL ** -0.5),
        'w_up': nrm(ks[15], (DEPTH, D_MODEL, D_FF), D_MODEL ** -0.5),
        'w_down': nrm(ks[16], (DEPTH, D_FF, D_MODEL), D_FF ** -0.5),
        'norm_final': 1.0 + nrm(ks[17], (D_MODEL,), 0.05),
    }


def reference(x_prompt, x_sample, cache_a_k, cache_a_v, cache_b_k, cache_b_v, w_in, norm_mix,
              rel_table, sinks, norm_grp_a, norm_grp_b, w_out, norm_ffn, w_gate, w_up, w_down,
              norm_final):
    xp = x_prompt
    xs = x_sample
    pa_k, pa_v, pb_k, pb_v = [], [], [], []
    sa_k, sa_v, sb_k, sb_v = [], [], [], []
    for l in range(DEPTH):
        w = (w_in[l], norm_mix[l], rel_table[l], sinks[l], norm_grp_a[l], norm_grp_b[l],
             w_out[l], norm_ffn[l], w_gate[l], w_up[l], w_down[l])
        xp, ak, av, bk, bv = prompt_layer(xp, *w)
        pa_k.append(ak); pa_v.append(av); pb_k.append(bk); pb_v.append(bv)
        xs, ak, av, bk, bv = sample_layer(xs, cache_a_k[l], cache_a_v[l], cache_b_k[l], cache_b_v[l], *w)
        sa_k.append(ak); sa_v.append(av); sb_k.append(bk); sb_v.append(bv)
    y_prompt = rmsnorm(xp, norm_final)
    y_sample = rmsnorm(xs, norm_final)
    return (y_prompt, y_sample,
            jnp.stack(pa_k), jnp.stack(pa_v), jnp.stack(pb_k), jnp.stack(pb_v),
            jnp.stack(sa_k), jnp.stack(sa_v), jnp.stack(sb_k), jnp.stack(sb_v))
```

```cpp
#include <hip/hip_runtime.h>
#include <hip/hip_cooperative_groups.h>
#include <cstdio>
#include <cstdint>
namespace cg = cooperative_groups;
namespace pg8 {
#define PG8_LAS __attribute__((address_space(3)))
typedef unsigned short bf16_t;
typedef short bf16x8 __attribute__((ext_vector_type(8)));
typedef float f32x4 __attribute__((ext_vector_type(4)));
typedef unsigned u32x4 __attribute__((ext_vector_type(4)));
constexpr int BM = 256, BK = 64, HALF = 128, HTB = HALF * BK * 2  , STAGE_BYTES = 8 * HTB, NXCD = 8, WGM = 8;

__host__ __device__ __forceinline__ int lds_byte(int r, int c) { const int st = (r >> 4) * 2 + (c >> 5), rr = r & 15, cc = c & 31, ob = rr * 64 + cc * 2; return st * 1024 + (ob ^ (((ob >> 9) & 1) << 5)); }
__host__ __device__ __forceinline__ void stage_rc(int b, int& R, int& C) { const int st = b / 1024, sb = b % 1024, swz = sb ^ (((sb >> 9) & 1) << 5); R = (st >> 1) * 16 + swz / 64; C = (st & 1) * 32 + (swz % 64) / 2; }
__host__ __device__ __forceinline__ int perm32(int rho) { const int n = rho >> 4, i = rho & 15; return 8 * (i >> 2) + 4 * n + (i & 3); }

struct Unit { int pm, pn, k0; };
struct Gemm { const bf16_t* A; const bf16_t* Bt; int M, N, K, KL; };

struct StaticOrder {
    int nM, nN, nwg, G, c;
    __host__ __device__ void init(int M, int N, int G_, int c_) { nM = M / BM; nN = N / BM; nwg = nM * nN; G = G_; c = c_; }
    __host__ __device__ bool next(int i, Unit& u) const {
        const long L = (long)i * G + c; if (L >= nwg) return false;
        int wgid = (int)L; { const int q = nwg / NXCD, r = nwg % NXCD, xcd = wgid % NXCD, off = wgid / NXCD; wgid = (xcd < r ? xcd * (q + 1) : r * (q + 1) + (xcd - r) * q) + off; }
        const int nig = WGM * nN, gid = wgid / nig, fm = gid * WGM, gsz = (nM - fm) < WGM ? (nM - fm) : WGM;
        u.pm = fm + ((wgid % nig) % gsz); u.pn = (wgid % nig) / gsz; u.k0 = 0; return true;
    }
    __device__ __forceinline__ void a_ready(const Unit&) const {}
    __device__ __forceinline__ void done(const Unit&) const {}
};
__device__ __forceinline__ unsigned cvt_pk_bf16(float lo, float hi) { unsigned r; asm volatile("v_cvt_pk_bf16_f32 %0, %1, %2" : "=v"(r) : "v"(lo), "v"(hi)); return r; }
typedef float f32x2 __attribute__((ext_vector_type(2)));
template <class Epi, class Sched, bool ALIGN_EPI = false, bool SP2 = false, bool HALFM = false  >
__device__ __forceinline__ void gemm_phase(PG8_LAS unsigned char* lds, const Gemm g, const Sched& S, const Epi& E) {
    int tid_l = threadIdx.x; asm volatile("" : "+v"(tid_l));
    const int tid = tid_l, wid = __builtin_amdgcn_readfirstlane(tid >> 6), lane = tid & 63, wr = wid >> 2, wc = wid & 3, fr = lane & 15, fq = lane >> 4;
    const int K = g.K, nt = g.KL / BK;
    unsigned voffA[2], voffB[2];
#pragma unroll
    for (int i = 0; i < 2; ++i) { int R, C; stage_rc(tid * 16 + i * 8192, R, C); const int Rb = Epi::PERM ? ((R & ~31) + perm32(R & 31)) : R;
        voffA[i] = (unsigned)(R * K + C) * 2u; voffB[i] = (unsigned)(Rb * K + C) * 2u; }
    const size_t kstep = (size_t)(BK * 2);
    const size_t hstep = (size_t)HALF * K * 2;
    const size_t tstep = 2 * hstep;
    const unsigned ldsw = (unsigned)wid * 1024u;
    const int aoff = lds_byte(wr * 64 + fr, fq * 8), boff = lds_byte(wc * 32 + fr, fq * 8);
#define PG8_SA(b, h) (((b) * 2 + (h)) * HTB)
#define PG8_SB(b, h) ((4 + (b) * 2 + (h)) * HTB)
#define PG8_STAGE(bufoff, gbase, voff) do { _Pragma("unroll") for (int _i = 0; _i < 2; ++_i) \
        __builtin_amdgcn_global_load_lds((const unsigned*)((const char*)(gbase) + (voff)[_i]), (PG8_LAS unsigned*)(lds + (bufoff) + ldsw + _i * 8192), 16, 0, 0); } while (0)
#define PG8_LDA(dst, b, h) do { _Pragma("unroll") for (int m = 0; m < 4; ++m) _Pragma("unroll") for (int k = 0; k < 2; ++k) dst[m][k] = *(const PG8_LAS bf16x8*)(lds + PG8_SA(b, h) + aoff + m * 2048 + k * 1024); } while (0)
#define PG8_LDB(dst, b, h) do { _Pragma("unroll") for (int n = 0; n < 2; ++n) _Pragma("unroll") for (int k = 0; k < 2; ++k) dst[n][k] = *(const PG8_LAS bf16x8*)(lds + PG8_SB(b, h) + boff + n * 2048 + k * 1024); } while (0)
#define PG8_MMA(ai, bj, At, Bt) do { __builtin_amdgcn_s_setprio(1); _Pragma("unroll") for (int m = 0; m < 4; ++m) _Pragma("unroll") for (int n = 0; n < 2; ++n) _Pragma("unroll") for (int k = 0; k < 2; ++k) \
        acc[ai][bj][m][n] = __builtin_amdgcn_mfma_f32_16x16x32_bf16(Bt[n][k], At[m][k], acc[ai][bj][m][n], 0, 0, 0); __builtin_amdgcn_s_setprio(0); } while (0)
#define PG8_WAIT_V(n) asm volatile("s_waitcnt vmcnt(" #n ")" ::: "memory")
#define PG8_WAIT_L(n) asm volatile("s_waitcnt lgkmcnt(" #n ")" ::: "memory")
#define PG8_BAR __builtin_amdgcn_s_barrier()
#define PG8_SCHED __builtin_amdgcn_sched_barrier(0)
    Unit cur, nxt; int ui = 0;
    if (!S.next(0, cur)) return;
    f32x4 acc[2][2][4][2];
#pragma unroll
    for (int a = 0; a < 2; ++a)
#pragma unroll
        for (int b = 0; b < 2; ++b)
#pragma unroll
            for (int m = 0; m < 4; ++m)
#pragma unroll
                for (int n = 0; n < 2; ++n) acc[a][b][m][n] = (f32x4){0.f, 0.f, 0.f, 0.f};
    bf16x8 At[4][2], B0[2][2], B1[2][2];
    const char* cA = (const char*)g.A + (size_t)cur.pm * tstep + (size_t)cur.k0 * 2; const char* cB = (const char*)g.Bt + (size_t)cur.pn * tstep + (size_t)cur.k0 * 2;
    S.a_ready(cur);
    if constexpr (SP2) {
        PG8_STAGE(PG8_SB(0, 0), cB, voffB); PG8_STAGE(PG8_SB(0, 1), cB + hstep, voffB); PG8_STAGE(PG8_SA(0, 0), cA, voffA); PG8_STAGE(PG8_SA(0, 1), cA + hstep, voffA);
        if (wr == 1) PG8_BAR;
        PG8_WAIT_V(2); PG8_BAR;
        PG8_STAGE(PG8_SB(1, 0), cB + kstep, voffB); PG8_STAGE(PG8_SA(1, 0), cA + kstep, voffA); PG8_STAGE(PG8_SB(1, 1), cB + hstep + kstep, voffB);
        PG8_WAIT_V(6); PG8_BAR;
    } else {
        PG8_STAGE(PG8_SB(0, 0), cB, voffB); PG8_STAGE(PG8_SA(0, 0), cA, voffA); PG8_STAGE(PG8_SB(0, 1), cB + hstep, voffB); PG8_STAGE(PG8_SA(0, 1), cA + hstep, voffA);
        if (wr == 1) PG8_BAR;
        PG8_WAIT_V(4); PG8_BAR;
        PG8_STAGE(PG8_SB(1, 0), cB + kstep, voffB); PG8_STAGE(PG8_SA(1, 0), cA + kstep, voffA); PG8_STAGE(PG8_SB(1, 1), cB + hstep + kstep, voffB);
        PG8_WAIT_V(6); PG8_BAR;
    }
    for (;;) {
        const bool has_next = S.next(ui + 1, nxt);
        const char* nA = has_next ? (const char*)g.A + (size_t)nxt.pm * tstep + (size_t)nxt.k0 * 2 : cA; const char* nB = has_next ? (const char*)g.Bt + (size_t)nxt.pn * tstep + (size_t)nxt.k0 * 2 : cB;
        for (int t = 0; t < nt; t += 2) {
            const bool last = (t == nt - 2);
            const char* a1 = cA + (size_t)(t + 1) * kstep;
            const char* a2 = last ? nA : cA + (size_t)(t + 2) * kstep; const char* b2 = last ? nB : cB + (size_t)(t + 2) * kstep;
            const char* a3 = a2 + kstep; const char* b3 = b2 + kstep;
            if (last && has_next) S.a_ready(nxt);
            if constexpr (SP2) {
            PG8_LDB(B0, 0, 0); PG8_LDB(B1, 0, 1); PG8_SCHED; PG8_LDA(At, 0, 0); PG8_STAGE(PG8_SA(1, 1), a1 + hstep, voffA);
            PG8_WAIT_V(8); PG8_WAIT_L(0); PG8_BAR; PG8_MMA(0, 0, At, B0); PG8_MMA(0, 1, At, B1); PG8_BAR; PG8_SCHED;
            if constexpr (!HALFM) { PG8_LDA(At, 0, 1); } PG8_STAGE(PG8_SB(0, 0), b2, voffB); PG8_STAGE(PG8_SB(0, 1), b2 + hstep, voffB); PG8_STAGE(PG8_SA(0, 0), a2, voffA);
            PG8_WAIT_V(8); PG8_WAIT_L(0); PG8_BAR; if constexpr (!HALFM) { PG8_MMA(1, 0, At, B0); PG8_MMA(1, 1, At, B1); } PG8_BAR; PG8_SCHED;
            PG8_LDB(B0, 1, 0); PG8_LDB(B1, 1, 1); PG8_SCHED; PG8_LDA(At, 1, 0); PG8_STAGE(PG8_SA(0, 1), a2 + hstep, voffA);
            PG8_WAIT_V(8); PG8_WAIT_L(0); PG8_BAR; PG8_MMA(0, 0, At, B0); PG8_MMA(0, 1, At, B1); PG8_BAR; PG8_SCHED;
            if constexpr (!HALFM) { PG8_LDA(At, 1, 1); } PG8_STAGE(PG8_SB(1, 0), b3, voffB); PG8_STAGE(PG8_SB(1, 1), b3 + hstep, voffB); PG8_STAGE(PG8_SA(1, 0), a3, voffA);
            PG8_WAIT_V(8); PG8_WAIT_L(0); PG8_BAR; if constexpr (!HALFM) { PG8_MMA(1, 0, At, B0); PG8_MMA(1, 1, At, B1); } PG8_BAR; PG8_SCHED;
            } else {
            PG8_LDB(B0, 0, 0); PG8_SCHED; PG8_LDA(At, 0, 0); PG8_STAGE(PG8_SA(1, 1), a1 + hstep, voffA);
            PG8_WAIT_L(8); PG8_BAR; PG8_WAIT_L(0); PG8_MMA(0, 0, At, B0); PG8_BAR; PG8_SCHED;
            PG8_LDB(B1, 0, 1); PG8_STAGE(PG8_SB(0, 0), b2, voffB);
            PG8_BAR; PG8_WAIT_L(0); PG8_MMA(0, 1, At, B1); PG8_BAR;
            PG8_LDA(At, 0, 1); PG8_STAGE(PG8_SA(0, 0), a2, voffA);
            PG8_BAR; PG8_WAIT_L(0); PG8_MMA(1, 0, At, B0); PG8_BAR; PG8_SCHED;
            PG8_STAGE(PG8_SB(0, 1), b2 + hstep, voffB);
            PG8_WAIT_V(6); PG8_BAR; PG8_MMA(1, 1, At, B1); PG8_BAR;
            PG8_LDB(B0, 1, 0); PG8_SCHED; PG8_LDA(At, 1, 0); PG8_STAGE(PG8_SA(0, 1), a2 + hstep, voffA);
            PG8_WAIT_L(8); PG8_BAR; PG8_WAIT_L(0); PG8_MMA(0, 0, At, B0); PG8_BAR; PG8_SCHED;
            PG8_LDB(B1, 1, 1); PG8_STAGE(PG8_SB(1, 0), b3, voffB);
            PG8_BAR; PG8_WAIT_L(0); PG8_MMA(0, 1, At, B1); PG8_BAR;
            PG8_LDA(At, 1, 1); PG8_STAGE(PG8_SA(1, 0), a3, voffA);
            PG8_BAR; PG8_WAIT_L(0); PG8_MMA(1, 0, At, B0); PG8_BAR; PG8_SCHED;
            PG8_STAGE(PG8_SB(1, 1), b3 + hstep, voffB);
            PG8_WAIT_V(6); PG8_BAR; PG8_MMA(1, 1, At, B1); PG8_BAR;
            }
        }
        if constexpr (ALIGN_EPI) { if (wr == 0) PG8_BAR; }
        if constexpr (!Epi::AFTER_DRAIN) { E(acc, cur, wr, wc, fr, fq); S.done(cur); }
        if (!has_next) break;
#pragma unroll
        for (int a = 0; a < 2; ++a)
#pragma unroll
            for (int b = 0; b < 2; ++b)
#pragma unroll
                for (int m = 0; m < 4; ++m)
#pragma unroll
                    for (int n = 0; n < 2; ++n) acc[a][b][m][n] = (f32x4){0.f, 0.f, 0.f, 0.f};
        cur = nxt; cA = nA; cB = nB; ++ui;
        if constexpr (ALIGN_EPI) { if (wr == 1) PG8_BAR; }
    }
    PG8_WAIT_V(0);
    if constexpr (!ALIGN_EPI) { if (wr == 0) PG8_BAR; }
    PG8_BAR;
    if constexpr (Epi::AFTER_DRAIN) { E.fused(acc, cur, wr, wc, fr, fq, lds, wid, lane); S.done(cur); }
#undef PG8_SA
#undef PG8_SB
#undef PG8_STAGE
#undef PG8_LDA
#undef PG8_LDB
#undef PG8_MMA
#undef PG8_WAIT_V
#undef PG8_WAIT_L
#undef PG8_BAR
#undef PG8_SCHED
}
}

#define LAS __attribute__((address_space(3)))
typedef unsigned short bf16_t;
typedef short bf16x8 __attribute__((ext_vector_type(8)));
typedef float f32x4 __attribute__((ext_vector_type(4)));
typedef float f32x16 __attribute__((ext_vector_type(16)));
typedef unsigned u32x4 __attribute__((ext_vector_type(4)));
typedef unsigned u32x2 __attribute__((ext_vector_type(2)));
using pg8::cvt_pk_bf16;

constexpr int DM = 2048, SEQ = 4096, NB = 8, MP = NB * SEQ, MS = 128, MV = MP + MS, MPAD = 33024;
constexpr int DIN = 4352, DFF = 5632, NGU = 2 * DFF;
constexpr int SKA = 544, SKB = 160;
constexpr float EPS = 1e-6f, LOG2E = 1.4426950408889634f, QSCALE = 0.125f * LOG2E;
constexpr size_t O_AKP = (size_t)MV * DM, O_AVP = O_AKP + 8 * 512 * 1024, O_BKP = O_AVP + 8 * 512 * 1024, O_BVP = O_BKP + 8 * 128 * 128,
                 O_AKS = O_BVP + 8 * 128 * 128, O_AVS = O_AKS + 8 * 16 * 1024, O_BKS = O_AVS + 8 * 16 * 1024, O_BVS = O_BKS + 8 * 16 * 128, O_END = O_BVS + 8 * 16 * 128;
constexpr size_t MiB = 1u << 20;
constexpr size_t WS_CTL = 0, WS_SSQ1 = 64 * 1024, WS_SSQ2 = 256 * 1024, WS_BAR = 768 * 1024, BAR_BYTES = 16384;
constexpr size_t WS_WIN = 1 * MiB, WS_WOUT = 18 * MiB, WS_WGU = 26 * MiB, WS_WD = 70 * MiB, WS_KSA = 92 * MiB, WS_VTSA = 101 * MiB, WS_KSB = 110 * MiB, WS_VTSB = 111 * MiB,
                 WS_O = 112 * MiB, WS_X1B = 241 * MiB, WS_VTA = 370 * MiB, WS_VTB = 434 * MiB, WS_KPB = 442 * MiB,
                 WS_XN = 450 * MiB, WS_QA = 579 * MiB, WS_QB = 644 * MiB, WS_KPA = 709 * MiB, WS_ACT = 450 * MiB, WS_END = 805 * MiB;
static_assert(WS_WIN + (size_t)DIN * DM * 2 <= WS_WOUT && WS_WGU + (size_t)NGU * DM * 2 <= WS_WD && WS_WD + (size_t)DM * DFF * 2 <= WS_KSA, "ws map 1");
static_assert(WS_O + (size_t)MPAD * DM * 2 <= WS_X1B && WS_X1B + (size_t)MPAD * DM * 2 <= WS_VTA && WS_XN + (size_t)MPAD * DM * 2 <= WS_QA, "ws map 2");
static_assert(WS_QA + (size_t)MPAD * 1024 * 2 <= WS_QB && WS_QB + (size_t)MPAD * 1024 * 2 <= WS_KPA && WS_KPA + (size_t)MP * 1024 * 2 <= WS_END && WS_ACT + (size_t)MPAD * DFF * 2 <= WS_END, "ws map 3");
constexpr int LDS_BYTES = 147456, OT_STRIDE = 2064, L_OT = 0, L_SSQ = 64 * OT_STRIDE, L_BIAS = L_SSQ + 2048, L_CTL = L_BIAS + 8 * 1408;
static_assert(L_CTL + 64 <= LDS_BYTES, "lds map");

struct Args { const float* in[18]; float* out; unsigned char* ws; };
enum { I_XP = 0, I_XS, I_CAK, I_CAV, I_CBK, I_CBV, I_WIN, I_NMIX, I_REL, I_SINK, I_NGA, I_NGB, I_WOUT, I_NFFN, I_WG, I_WU, I_WD, I_NFIN };

#define LDS_WAIT() asm volatile("s_waitcnt lgkmcnt(0)" ::: "memory")
__device__ __forceinline__ float wave_sum(float v) {
#pragma unroll
    for (int o = 1; o < 64; o <<= 1) v += __shfl_xor(v, o);
    return v;
}
__device__ __forceinline__ u32x4 pack8(f32x4 a, f32x4 b) { u32x4 w; w.x = cvt_pk_bf16(a[0], a[1]); w.y = cvt_pk_bf16(a[2], a[3]); w.z = cvt_pk_bf16(b[0], b[1]); w.w = cvt_pk_bf16(b[2], b[3]); return w; }

__device__ __forceinline__ int pi32(int i) { return (i & ~12) | ((i & 4) << 1) | ((i & 8) >> 1); }
__device__ __forceinline__ void p0_transpose_item(const float* __restrict__ W, int K, int N, const float* __restrict__ g, const float* __restrict__ g2, bf16_t* WT, int mode, LAS float* scr, int item, int lane) {
    const int nblk = N / 64, kb = item / nblk, nb = item % nblk, k0 = 64 * kb, n0 = 64 * nb;
    const int kk = lane >> 4, cq = lane & 15;
    f32x4 v[16]; float sc[16];
#pragma unroll
    for (int i = 0; i < 16; ++i) { const int k = k0 + 4 * i + kk; v[i] = *(const f32x4*)(W + (size_t)k * N + n0 + 4 * cq); sc[i] = g ? ((g2 && k >= 1024) ? g2[k - 1024] : g[k]) : 1.f; }
#pragma unroll
    for (int i = 0; i < 16; ++i) { LAS float* d = scr + (4 * i + kk) * 65 + 4 * cq; d[0] = v[i].x * sc[i]; d[1] = v[i].y * sc[i]; d[2] = v[i].z * sc[i]; d[3] = v[i].w * sc[i]; }
    LDS_WAIT(); asm volatile("" ::: "memory");
    const int c = lane & 7;
    const int rowbase = (mode == 0) ? n0 : (256 * (n0 >> 7) + (n0 & 127) + (mode == 2 ? 128 : 0));
#pragma unroll
    for (int j = 0; j < 8; ++j) { const int n = (lane >> 3) + 8 * j; const LAS float* s_ = scr + (8 * c) * 65 + n;
        u32x4 o; o.x = cvt_pk_bf16(s_[0 * 65], s_[1 * 65]); o.y = cvt_pk_bf16(s_[2 * 65], s_[3 * 65]); o.z = cvt_pk_bf16(s_[4 * 65], s_[5 * 65]); o.w = cvt_pk_bf16(s_[6 * 65], s_[7 * 65]);
        *(u32x4*)(WT + (size_t)(rowbase + n) * K + k0 + 8 * c) = o; }
    LDS_WAIT(); asm volatile("" ::: "memory");
}

__device__ __forceinline__ void p0_prologue(const Args& a, LAS unsigned char* lds, int bx, int G, int wave, int lane) {
    unsigned char* ws = a.ws;
    if (wave < 4) {
        const int gw = bx * 4 + wave, NGW = G * 4;
        LAS float* scr = (LAS float*)(lds + wave * 16896);
        bf16_t* WIN = (bf16_t*)(ws + WS_WIN); bf16_t* WOUT = (bf16_t*)(ws + WS_WOUT); bf16_t* WGU = (bf16_t*)(ws + WS_WGU); bf16_t* WD = (bf16_t*)(ws + WS_WD);
        constexpr int IT_IN = (DM / 64) * (DIN / 64), IT_OUT = (DM / 64) * (DM / 64), IT_G = (DM / 64) * (DFF / 64), IT_D = (DFF / 64) * (DM / 64);
        constexpr int NITEMS = IT_IN + IT_OUT + 2 * IT_G + IT_D;
        for (int it = gw; it < NITEMS; it += NGW) {
            int r = it;
            if (r < IT_IN) { p0_transpose_item(a.in[I_WIN], DM, DIN, a.in[I_NMIX], nullptr, WIN, 0, scr, r, lane); continue; } r -= IT_IN;
            if (r < IT_OUT) { p0_transpose_item(a.in[I_WOUT], DM, DM, a.in[I_NGA], a.in[I_NGB], WOUT, 0, scr, r, lane); continue; } r -= IT_OUT;
            if (r < IT_G) { p0_transpose_item(a.in[I_WG], DM, DFF, a.in[I_NFFN], nullptr, WGU, 1, scr, r, lane); continue; } r -= IT_G;
            if (r < IT_G) { p0_transpose_item(a.in[I_WU], DM, DFF, a.in[I_NFFN], nullptr, WGU, 2, scr, r, lane); continue; } r -= IT_G;
            p0_transpose_item(a.in[I_WD], DFF, DM, nullptr, nullptr, WD, 0, scr, r, lane);
        }
        return;
    }
    const int gw = bx * 4 + (wave - 4), NGW = G * 4;
    bf16_t* XN = (bf16_t*)(ws + WS_XN); float* xscale = (float*)(ws + WS_SSQ2);
    for (int m0 = gw; m0 < MV; m0 += 2 * NGW) {
        const int m1 = m0 + NGW; const bool two = m1 < MV;
        const float* xrow0 = (m0 < MP) ? a.in[I_XP] + (size_t)m0 * DM : a.in[I_XS] + (size_t)(m0 - MP) * DM;
        const float* xrow1 = two ? ((m1 < MP) ? a.in[I_XP] + (size_t)m1 * DM : a.in[I_XS] + (size_t)(m1 - MP) * DM) : xrow0;
        const f32x4* xr0 = (const f32x4*)xrow0 + lane; const f32x4* xr1 = (const f32x4*)xrow1 + lane;
        f32x4 v0[8], v1[8]; float s0 = 0.f, s1 = 0.f;
#pragma unroll
        for (int j = 0; j < 8; ++j) { v0[j] = xr0[64 * j]; v1[j] = xr1[64 * j]; }
#pragma unroll
        for (int j = 0; j < 8; ++j) { s0 += (v0[j].x * v0[j].x + v0[j].y * v0[j].y) + (v0[j].z * v0[j].z + v0[j].w * v0[j].w); s1 += (v1[j].x * v1[j].x + v1[j].y * v1[j].y) + (v1[j].z * v1[j].z + v1[j].w * v1[j].w); }
        const float q0 = sqrtf(wave_sum(s0) * (1.f / DM) + EPS), q1 = sqrtf(wave_sum(s1) * (1.f / DM) + EPS), r0 = 1.0f / q0, r1 = 1.0f / q1;
        if (lane == 0) { xscale[m0] = q0; if (two) xscale[m1] = q1; }
        u32x2* o0 = (u32x2*)(XN + (size_t)m0 * DM) + lane;
#pragma unroll
        for (int j = 0; j < 8; ++j) { u32x2 w; w.x = cvt_pk_bf16(v0[j].x * r0, v0[j].y * r0); w.y = cvt_pk_bf16(v0[j].z * r0, v0[j].w * r0); o0[64 * j] = w; }
        if (two) { u32x2* o1 = (u32x2*)(XN + (size_t)m1 * DM) + lane;
#pragma unroll
            for (int j = 0; j < 8; ++j) { u32x2 w; w.x = cvt_pk_bf16(v1[j].x * r1, v1[j].y * r1); w.y = cvt_pk_bf16(v1[j].z * r1, v1[j].w * r1); o1[64 * j] = w; } }
    }
    const int gt = gw * 64 + lane, NGT = NGW * 64;
    unsigned char* KFSA = ws + WS_KSA; unsigned char* KFSB = ws + WS_KSB; unsigned char* VFSA = ws + WS_VTSA; unsigned char* VFSB = ws + WS_VTSB;
    for (int i = gt; i < 8 * SKA * 128; i += NGT) { const int ch = i & 127, s_ = (i >> 7) % SKA, b = (i >> 7) / SKA, head = ch >> 3, j = ch & 7;
        if (s_ >= 512 && s_ < 528) continue;
        u32x4 w = (u32x4){0u, 0u, 0u, 0u};
        if (s_ < 512) { const f32x4* src = (const f32x4*)(a.in[I_CAK] + ((size_t)(b * 512 + s_) * 1024 + ch * 8)); w = pack8(src[0], src[1]); }
        *(u32x4*)(KFSA + ((size_t)((b * 16 + head) * 17 + (s_ >> 5)) * 4096 + (j >> 1) * 1024 + ((j & 1) * 32 + pi32(s_ & 31)) * 16)) = w; }
    for (int i = gt; i < 8 * SKB * 16; i += NGT) { const int ch = i & 15, s_ = (i >> 4) % SKB, b = (i >> 4) / SKB, head = ch >> 3, j = ch & 7;
        if (s_ >= 128 && s_ < 144) continue;
        u32x4 w = (u32x4){0u, 0u, 0u, 0u};
        if (s_ < 128) { const f32x4* src = (const f32x4*)(a.in[I_CBK] + ((size_t)(b * 128 + s_) * 128 + ch * 8)); w = pack8(src[0], src[1]); }
        *(u32x4*)(KFSB + ((size_t)((b * 2 + head) * 5 + (s_ >> 5)) * 4096 + (j >> 1) * 1024 + ((j & 1) * 32 + pi32(s_ & 31)) * 16)) = w; }
    for (int it = gw; it < 8 * 16 * (SKA / 8); it += NGW) { const int sb = it % (SKA / 8), bh = it / (SKA / 8), b = bh >> 4, h = bh & 15, s0 = sb * 8;
        if (s0 >= 512 && s0 < 528) continue;
        u32x4 w = (u32x4){0u, 0u, 0u, 0u};
        if (s0 < 512) { float t[8];
#pragma unroll
            for (int j = 0; j < 8; ++j) t[j] = a.in[I_CAV][((size_t)(b * 512 + s0 + j) * 16 + h) * 64 + lane];
            w.x = cvt_pk_bf16(t[0], t[1]); w.y = cvt_pk_bf16(t[2], t[3]); w.z = cvt_pk_bf16(t[4], t[5]); w.w = cvt_pk_bf16(t[6], t[7]); }
        *(u32x4*)(VFSA + ((size_t)(bh * 17 + (s0 >> 5)) * 4096 + (lane >> 5) * 2048 + ((s0 & 31) >> 4) * 1024 + (((s0 & 15) >> 3) * 32 + (lane & 31)) * 16)) = w; }
    for (int it = gw; it < 8 * 2 * (SKB / 8); it += NGW) { const int sb = it % (SKB / 8), bh = it / (SKB / 8), b = bh >> 1, h = bh & 1, s0 = sb * 8;
        if (s0 >= 128 && s0 < 144) continue;
        u32x4 w = (u32x4){0u, 0u, 0u, 0u};
        if (s0 < 128) { float t[8];
#pragma unroll
            for (int j = 0; j < 8; ++j) t[j] = a.in[I_CBV][((size_t)(b * 128 + s0 + j) * 2 + h) * 64 + lane];
            w.x = cvt_pk_bf16(t[0], t[1]); w.y = cvt_pk_bf16(t[2], t[3]); w.z = cvt_pk_bf16(t[4], t[5]); w.w = cvt_pk_bf16(t[6], t[7]); }
        *(u32x4*)(VFSB + ((size_t)(bh * 5 + (s0 >> 5)) * 4096 + (lane >> 5) * 2048 + ((s0 & 31) >> 4) * 1024 + (((s0 & 15) >> 3) * 32 + (lane & 31)) * 16)) = w; }
    for (int i = gt; i < MS * DM / 4; i += NGT) ((f32x4*)(a.out + (size_t)MP * DM))[i] = ((const f32x4*)a.in[I_XS])[i];
    float* ssq1 = (float*)(ws + WS_SSQ1); float* ssq2 = (float*)(ws + WS_SSQ2);
    for (int i = gt; i < MPAD; i += NGT) ssq1[i] = 0.f;
    (void)ssq2;
    if (gt == 0) *(unsigned*)(ws + WS_CTL) = 0u;
    for (int i = gt; i < (int)(BAR_BYTES / 4); i += NGT) ((unsigned*)(ws + WS_BAR))[i] = 0u;
}

struct EpiIn {
    static constexpr bool PERM = true, AFTER_DRAIN = false;
    bf16_t *QA, *QB, *KPA, *KSA, *KPB, *KSB, *VTA, *VTSA, *VTB, *VTSB; float* out;
    static __device__ __forceinline__ void rope(f32x4& v0, f32x4& v1, int pos, int fq) {
        float o[8], mine[8] = {v0[0], v0[1], v0[2], v0[3], v1[0], v1[1], v1[2], v1[3]};
#pragma unroll
        for (int j = 0; j < 8; ++j) o[j] = __shfl_xor(mine[j], 16);
        if (fq < 2) {
            const float invf[8] = {1.0f, 0.1939227432012558f, 0.03760603070259094f, 0.007292664609849453f, 0.0014142135623842478f, 0.00027424818836152554f, 5.318296098266728e-05f, 1.0313386155758053e-05f};
            const float sg = (fq == 0) ? -1.f : 1.f;
#pragma unroll
            for (int j = 0; j < 8; ++j) { const float ang = (float)pos * invf[j]; double rev = (double)ang * 0.15915494309189535; rev -= __builtin_rint(rev); const float fr_ = (float)rev;
                const float c = __builtin_amdgcn_cosf(fr_), s = __builtin_amdgcn_sinf(fr_); mine[j] = mine[j] * c + sg * o[j] * s; }
            v0 = (f32x4){mine[0], mine[1], mine[2], mine[3]}; v1 = (f32x4){mine[4], mine[5], mine[6], mine[7]};
        }
    }
    __device__ __forceinline__ void operator()(const f32x4 (&acc)[2][2][4][2], const pg8::Unit& u, int wr, int wc, int fr, int fq) const {
        const int pn = u.pn, pm = u.pm; const bool samp = (pm >= 128);
        const int rbase = pm * 256 + wr * 64 + fr, cw = wc * 32 + fq * 8;
        if (pn < 4 || (pn >= 12 && pn < 16)) {
            const bool isB = pn >= 12; bf16_t* Q = isB ? QB : QA; const int c0 = (pn & 3) * 256 + cw; const bool rp = isB && ((wc & 1) == 0);
#pragma unroll
            for (int ai = 0; ai < 2; ++ai)
#pragma unroll
                for (int m = 0; m < 4; ++m) { const int row = rbase + ai * 128 + m * 16; const int pos = samp ? 2048 + (row & 15) : (row & 4095);
#pragma unroll
                    for (int bj = 0; bj < 2; ++bj) { f32x4 v0 = acc[ai][bj][m][0], v1 = acc[ai][bj][m][1];
                        if (rp) rope(v0, v1, pos, fq);
                        const int c = c0 + bj * 128, j = (c & 63) >> 3, lr = row & 63;
                        bf16_t* qd = samp ? Q + (size_t)row * 1024 + c : Q + ((size_t)(row >> 6) * 16 + (c >> 6)) * 4096 + ((lr >> 5) * 4 + (j >> 1)) * 512 + ((j & 1) * 32 + (lr & 31)) * 8;
                        *(u32x4*)qd = pack8(v0 * QSCALE, v1 * QSCALE); } }
        } else if (pn < 12) {
            const bool isV = pn >= 8; const int c0 = (pn - (isV ? 8 : 4)) * 256 + cw;
#pragma unroll
            for (int ai = 0; ai < 2; ++ai) { if (samp && ai == 1) continue;
#pragma unroll
                for (int m = 0; m < 4; ++m) { const int row = rbase + ai * 128 + m * 16; int t, nblk; unsigned char* base; float* od = nullptr;
                    if (!samp) { t = row & 4095; nblk = 128; base = (unsigned char*)(isV ? VTA : KPA) + (size_t)(row >> 12) * 16 * 128 * 4096;
                        if (t >= 3584) od = out + (isV ? O_AVP : O_AKP) + (size_t)((row >> 12) * 512 + t - 3584) * 1024; }
                    else { const int rs = row - MP; t = 512 + (rs & 15); nblk = 17; base = (unsigned char*)(isV ? VTSA : KSA) + (size_t)(rs >> 4) * 16 * 17 * 4096; od = out + (isV ? O_AVS : O_AKS) + (size_t)rs * 1024; }
                    const int toffk = (t >> 5) * 4096 + pi32(t & 31) * 16, toffv = (t >> 5) * 4096 + ((t & 31) >> 4) * 1024 + ((t & 15) >> 3) * 512 + (t & 7) * 2;
#pragma unroll
                    for (int bj = 0; bj < 2; ++bj) { const f32x4 v0 = acc[ai][bj][m][0], v1 = acc[ai][bj][m][1]; const int c = c0 + bj * 128, head = c >> 6, d0 = c & 63;
                        const u32x4 w = pack8(v0, v1); unsigned char* hb = base + (size_t)head * nblk * 4096;
                        if (!isV) { *(u32x4*)(hb + toffk + (d0 >> 4) * 1024 + ((d0 >> 3) & 1) * 512) = w; }
                        else { bf16_t* p = (bf16_t*)(hb + toffv + (d0 >> 5) * 2048 + (d0 & 31) * 16);
                            p[0] = (bf16_t)(w.x & 0xffffu); p[8] = (bf16_t)(w.x >> 16); p[16] = (bf16_t)(w.y & 0xffffu); p[24] = (bf16_t)(w.y >> 16);
                            p[32] = (bf16_t)(w.z & 0xffffu); p[40] = (bf16_t)(w.z >> 16); p[48] = (bf16_t)(w.w & 0xffffu); p[56] = (bf16_t)(w.w >> 16); }
                        if (od) { *(f32x4*)(od + c) = v0; *(f32x4*)(od + c + 4) = v1; } } } }
        } else {
            const bool rp = ((wc & 1) == 0); const int kvh = cw >> 6, d0 = cw & 63;
#pragma unroll
            for (int ai = 0; ai < 2; ++ai) { if (samp && ai == 1) continue;
#pragma unroll
                for (int m = 0; m < 4; ++m) { const int row = rbase + ai * 128 + m * 16;
                    unsigned char* kb_; unsigned char* vb_; float* ok = nullptr; float* ov = nullptr; int pos, t, nblk;
                    if (!samp) { const int b = row >> 12; t = row & 4095; pos = t; nblk = 128; kb_ = (unsigned char*)KPB + (size_t)b * 2 * 128 * 4096; vb_ = (unsigned char*)VTB + (size_t)b * 2 * 128 * 4096;
                        if (t >= 3968) { ok = out + O_BKP + (size_t)(b * 128 + t - 3968) * 128; ov = out + O_BVP + (size_t)(b * 128 + t - 3968) * 128; } }
                    else { const int rs = row - MP, b = rs >> 4; pos = 2048 + (rs & 15); t = 128 + (rs & 15); nblk = 5; kb_ = (unsigned char*)KSB + (size_t)b * 2 * 5 * 4096; vb_ = (unsigned char*)VTSB + (size_t)b * 2 * 5 * 4096;
                        ok = out + O_BKS + (size_t)rs * 128; ov = out + O_BVS + (size_t)rs * 128; }
                    const int toffk = (t >> 5) * 4096 + pi32(t & 31) * 16, toffv = (t >> 5) * 4096 + ((t & 31) >> 4) * 1024 + ((t & 15) >> 3) * 512 + (t & 7) * 2;
                    { f32x4 v0 = acc[ai][0][m][0], v1 = acc[ai][0][m][1];
                        if (rp) rope(v0, v1, pos, fq);
                        *(u32x4*)(kb_ + (size_t)kvh * nblk * 4096 + toffk + (d0 >> 4) * 1024 + ((d0 >> 3) & 1) * 512) = pack8(v0, v1);
                        if (ok) { *(f32x4*)(ok + cw) = v0; *(f32x4*)(ok + cw + 4) = v1; } }
                    { const f32x4 v0 = acc[ai][1][m][0], v1 = acc[ai][1][m][1];
                        const u32x4 w = pack8(v0, v1); bf16_t* p = (bf16_t*)(vb_ + (size_t)kvh * nblk * 4096 + toffv + (d0 >> 5) * 2048 + (d0 & 31) * 16);
                        p[0] = (bf16_t)(w.x & 0xffffu); p[8] = (bf16_t)(w.x >> 16); p[16] = (bf16_t)(w.y & 0xffffu); p[24] = (bf16_t)(w.y >> 16);
                        p[32] = (bf16_t)(w.z & 0xffffu); p[40] = (bf16_t)(w.z >> 16); p[48] = (bf16_t)(w.w & 0xffffu); p[56] = (bf16_t)(w.w >> 16);
                        if (ov) { *(f32x4*)(ov + cw) = v0; *(f32x4*)(ov + cw + 4) = v1; } } } }
        }
    }
};
template <bool FIRST> struct EpiRes {
    static constexpr bool PERM = false, AFTER_DRAIN = false;
    const float* xp; const float* xs; float* out; bf16_t* x1b; float* ssq;
    __device__ __forceinline__ void operator()(const f32x4 (&acc)[2][2][4][2], const pg8::Unit& u, int wr, int wc, int fr, int fq) const {
        const int pm = u.pm, col0 = u.pn * 256 + wc * 32 + 4 * fq;
#pragma unroll
        for (int ai = 0; ai < 2; ++ai) { if (pm >= 128 && ai == 1) continue;
            const int row0 = pm * 256 + ai * 128 + wr * 64 + fr;
            f32x4 res[4][2][2];
#pragma unroll
            for (int m = 0; m < 4; ++m) { const int row = row0 + m * 16;
                const float* rrow = FIRST ? ((pm < 128) ? xp + (size_t)row * DM + col0 : xs + (size_t)(row - MP) * DM + col0) : out + (size_t)row * DM + col0;
#pragma unroll
                for (int bj = 0; bj < 2; ++bj)
#pragma unroll
                    for (int n = 0; n < 2; ++n) res[m][bj][n] = *(const f32x4*)(rrow + bj * 128 + n * 16); }
#pragma unroll
            for (int m = 0; m < 4; ++m) { const int row = row0 + m * 16;
                float* orow = out + (size_t)row * DM + col0;
                float ss = 0.f;
#pragma unroll
                for (int bj = 0; bj < 2; ++bj)
#pragma unroll
                    for (int n = 0; n < 2; ++n) { const int c = bj * 128 + n * 16; const f32x4 v = acc[ai][bj][m][n] + res[m][bj][n];
                        if (!FIRST) *(f32x4*)(orow + c) = v;
                        ss += (v[0] * v[0] + v[1] * v[1]) + (v[2] * v[2] + v[3] * v[3]);
                        if (FIRST) { u32x2 w; w.x = cvt_pk_bf16(v[0], v[1]); w.y = cvt_pk_bf16(v[2], v[3]); *(u32x2*)(x1b + (size_t)row * DM + col0 + c) = w; } }
                if (FIRST) { ss += __shfl_xor(ss, 16); ss += __shfl_xor(ss, 32);
                    if (fq == 0) atomicAdd(ssq + row, ss); } } }
    }
};
struct EpiGU {
    static constexpr bool PERM = true, AFTER_DRAIN = false;
    bf16_t* act; const float* ssq1;
    __device__ __forceinline__ void operator()(const f32x4 (&acc)[2][2][4][2], const pg8::Unit& u, int wr, int wc, int fr, int fq) const {
        const int pm = u.pm, col0 = u.pn * 128 + wc * 32 + 8 * fq;
        float r1[2][4];
#pragma unroll
        for (int ai = 0; ai < 2; ++ai)
#pragma unroll
            for (int m = 0; m < 4; ++m) r1[ai][m] = (pm >= 128 && ai == 1) ? 0.f : ssq1[pm * 256 + ai * 128 + wr * 64 + m * 16 + fr];
        f32x4 gu[2][4][2];
#pragma unroll
        for (int ai = 0; ai < 2; ++ai)
#pragma unroll
            for (int m = 0; m < 4; ++m)
#pragma unroll
                for (int n = 0; n < 2; ++n) gu[ai][m][n] = acc[ai][0][m][n] * acc[ai][1][m][n];
#pragma unroll
        for (int ai = 0; ai < 2; ++ai)
#pragma unroll
            for (int m = 0; m < 4; ++m) r1[ai][m] = __builtin_amdgcn_rsqf(r1[ai][m] * (1.f / DM) + EPS);
#pragma unroll
        for (int ai = 0; ai < 2; ++ai) { if (pm >= 128 && ai == 1) continue;
#pragma unroll
            for (int m = 0; m < 4; ++m) { const int row = pm * 256 + ai * 128 + wr * 64 + m * 16 + fr;
                const float rr = r1[ai][m], rl = -rr * LOG2E, r2 = rr * rr;
                f32x4 o[2];
#pragma unroll
                for (int n = 0; n < 2; ++n) { const f32x4 g = acc[ai][0][m][n];
#pragma unroll
                    for (int e = 0; e < 4; ++e) o[n][e] = gu[ai][m][n][e] * r2 * __builtin_amdgcn_rcpf(1.0f + __builtin_amdgcn_exp2f(g[e] * rl)); }
                __builtin_nontemporal_store(pack8(o[0], o[1]), (u32x4*)(act + (size_t)row * DFF + col0)); } }
    }
};
struct EpiOut {
    static constexpr bool PERM = true, AFTER_DRAIN = false;
    const bf16_t* xn; const float* xscale; bf16_t* x1b; float* ssq;
    __device__ __forceinline__ void operator()(const f32x4 (&acc)[2][2][4][2], const pg8::Unit& u, int wr, int wc, int fr, int fq) const {
        const int row0 = u.pm * 256 + wr * 64 + fr; const size_t off0 = (size_t)row0 * DM + u.pn * 256 + wc * 32 + 8 * fq;
        u32x4 res[2][4][2]; float sc[2][4];
#pragma unroll
        for (int ai = 0; ai < 2; ++ai)
#pragma unroll
            for (int m = 0; m < 4; ++m) { sc[ai][m] = xscale[row0 + ai * 128 + m * 16];
#pragma unroll
                for (int bj = 0; bj < 2; ++bj) res[ai][m][bj] = *(const u32x4*)(xn + off0 + (size_t)(ai * 128 + m * 16) * DM + bj * 128); }
#pragma unroll
        for (int ai = 0; ai < 2; ++ai)
#pragma unroll
            for (int m = 0; m < 4; ++m) { float ss = 0.f; const float q = sc[ai][m];
#pragma unroll
                for (int bj = 0; bj < 2; ++bj) { const u32x4 w = res[ai][m][bj]; const f32x4 a0 = acc[ai][bj][m][0], a1 = acc[ai][bj][m][1];
                    const f32x4 v0 = (f32x4){__uint_as_float(w.x << 16), __uint_as_float(w.x & 0xffff0000u), __uint_as_float(w.y << 16), __uint_as_float(w.y & 0xffff0000u)} * q + a0;
                    const f32x4 v1 = (f32x4){__uint_as_float(w.z << 16), __uint_as_float(w.z & 0xffff0000u), __uint_as_float(w.w << 16), __uint_as_float(w.w & 0xffff0000u)} * q + a1;
                    ss += ((v0[0] * v0[0] + v0[1] * v0[1]) + (v0[2] * v0[2] + v0[3] * v0[3])) + ((v1[0] * v1[0] + v1[1] * v1[1]) + (v1[2] * v1[2] + v1[3] * v1[3]));
                    *(u32x4*)(x1b + off0 + (size_t)(ai * 128 + m * 16) * DM + bj * 128) = pack8(v0, v1); }
                ss += __shfl_xor(ss, 16); ss += __shfl_xor(ss, 32);
                if (fq == 0) atomicAdd(ssq + row0 + ai * 128 + m * 16, ss); }
    }
};
struct EpiDown {
    static constexpr bool PERM = true, AFTER_DRAIN = false;
    bf16_t* x;
    __device__ __forceinline__ void operator()(const f32x4 (&acc)[2][2][4][2], const pg8::Unit& u, int wr, int wc, int fr, int fq) const {
        bf16_t* base = x + (size_t)(u.pm * 256 + wr * 64 + fr) * DM + u.pn * 256 + wc * 32 + 8 * fq;
        u32x4 res[2][4][2];
#pragma unroll
        for (int ai = 0; ai < 2; ++ai)
#pragma unroll
            for (int m = 0; m < 4; ++m)
#pragma unroll
                for (int bj = 0; bj < 2; ++bj) res[ai][m][bj] = *(const u32x4*)(base + (size_t)(ai * 128 + m * 16) * DM + bj * 128);
#pragma unroll
        for (int ai = 0; ai < 2; ++ai)
#pragma unroll
            for (int m = 0; m < 4; ++m)
#pragma unroll
                for (int bj = 0; bj < 2; ++bj) { const u32x4 w = res[ai][m][bj]; const f32x4 a0 = acc[ai][bj][m][0], a1 = acc[ai][bj][m][1]; u32x4 o;
                    o.x = cvt_pk_bf16(__uint_as_float(w.x << 16) + a0[0], __uint_as_float(w.x & 0xffff0000u) + a0[1]);
                    o.y = cvt_pk_bf16(__uint_as_float(w.y << 16) + a0[2], __uint_as_float(w.y & 0xffff0000u) + a0[3]);
                    o.z = cvt_pk_bf16(__uint_as_float(w.z << 16) + a1[0], __uint_as_float(w.z & 0xffff0000u) + a1[1]);
                    o.w = cvt_pk_bf16(__uint_as_float(w.w << 16) + a1[2], __uint_as_float(w.w & 0xffff0000u) + a1[3]);
                    *(u32x4*)(base + (size_t)(ai * 128 + m * 16) * DM + bj * 128) = o; }
    }
};
struct SplitKOrder {
    int pm, npn, nks, kl, G, c;
    __device__ __forceinline__ bool next(int i, pg8::Unit& u) const { const int L = i * G + c; if (L >= npn * nks) return false; u.pm = pm; u.pn = L / nks; u.k0 = (L % nks) * kl; return true; }
    __device__ __forceinline__ void a_ready(const pg8::Unit&) const {}
    __device__ __forceinline__ void done(const pg8::Unit&) const {}
};
struct EpiAtomic {
    static constexpr bool PERM = false, AFTER_DRAIN = false;
    float* out;
    __device__ __forceinline__ void operator()(const f32x4 (&acc)[2][2][4][2], const pg8::Unit& u, int wr, int wc, int fr, int fq) const {
        const int pm = u.pm, col0 = u.pn * 256 + wc * 32 + 4 * fq;
#pragma unroll
        for (int ai = 0; ai < 2; ++ai) { if (pm >= 128 && ai == 1) continue;
#pragma unroll
            for (int m = 0; m < 4; ++m) { float* orow = out + (size_t)(pm * 256 + ai * 128 + wr * 64 + m * 16 + fr) * DM + col0;
#pragma unroll
                for (int bj = 0; bj < 2; ++bj)
#pragma unroll
                    for (int n = 0; n < 2; ++n)
#pragma unroll
                        for (int e = 0; e < 4; ++e) __hip_atomic_fetch_add(orow + bj * 128 + n * 16 + e, acc[ai][bj][m][n][e], __ATOMIC_RELAXED, __HIP_MEMORY_SCOPE_AGENT); } }
    }
};

__device__ __forceinline__ float swapmax(float m) { auto rr = __builtin_amdgcn_permlane32_swap(__float_as_uint(m), __float_as_uint(m), false, false); return fmaxf(__uint_as_float(rr[0]), __uint_as_float(rr[1])); }
__device__ __forceinline__ float swapsum(float m) { auto rr = __builtin_amdgcn_permlane32_swap(__float_as_uint(m), __float_as_uint(m), false, false); return __uint_as_float(rr[0]) + __uint_as_float(rr[1]); }
#define MFMA32(a, b, c) __builtin_amdgcn_mfma_f32_32x32x16_bf16((a), (b), (c), 0, 0, 0)
__device__ __forceinline__ void attn_head(const bf16_t* __restrict__ Qp, const unsigned char* __restrict__ Kt, const unsigned char* __restrict__ Vt, int nkeys, int relbase,
                                          const LAS float* btab, float m_init, float l_init, LAS unsigned char* otile, int ocol, float& ssq0, float& ssq1, int lane, bool qfrag) {
    const int r32 = lane & 31, hi = lane >> 5;
    bf16x8 qf[2][4];
#pragma unroll
    for (int qb = 0; qb < 2; ++qb)
#pragma unroll
        for (int d0 = 0; d0 < 4; ++d0) qf[qb][d0] = qfrag ? *(const bf16x8*)(Qp + (qb * 4 + d0) * 512 + lane * 8) : *(const bf16x8*)(Qp + (size_t)(qb * 32 + r32) * 1024 + d0 * 16 + hi * 8);
    f32x16 o[2][2];
#pragma unroll
    for (int qb = 0; qb < 2; ++qb)
#pragma unroll
        for (int db = 0; db < 2; ++db)
#pragma unroll
            for (int r = 0; r < 16; ++r) o[qb][db][r] = 0.f;
    float mref[2] = {m_init, m_init}, lrun[2] = {hi == 0 ? l_init : 0.f, hi == 0 ? l_init : 0.f};
    const unsigned char* kbase = Kt + lane * 16;
    const unsigned char* vbase = Vt + lane * 16;
    const int nblk = (nkeys + 31) >> 5;
    const float cfar = btab ? btab[256] : 0.f;
    bf16x8 kf[4], vf[2][2], kn[4], vn[2][2];
#pragma unroll
    for (int d0 = 0; d0 < 4; ++d0) kf[d0] = *(const bf16x8*)(kbase + d0 * 1024);
#pragma unroll
    for (int db = 0; db < 2; ++db)
#pragma unroll
        for (int ks = 0; ks < 2; ++ks) vf[db][ks] = *(const bf16x8*)(vbase + db * 2048 + ks * 1024);
    for (int kb = 0; kb < nblk; ++kb) {
        if (kb + 1 < nblk) {
            const unsigned char* kp = kbase + (size_t)(kb + 1) * 4096; const unsigned char* vp = vbase + (size_t)(kb + 1) * 4096;
#pragma unroll
            for (int d0 = 0; d0 < 4; ++d0) kn[d0] = *(const bf16x8*)(kp + d0 * 1024);
#pragma unroll
            for (int db = 0; db < 2; ++db)
#pragma unroll
                for (int ks = 0; ks < 2; ++ks) vn[db][ks] = *(const bf16x8*)(vp + db * 2048 + ks * 1024);
        }
        const int kb0 = kb * 32 + 8 * hi;
        const bool tail = (kb * 32 + 32 > nkeys);
        const bool far = (relbase - (kb * 32 + 31) >= 128);
#pragma unroll
        for (int qb = 0; qb < 2; ++qb) {
            const float sinit = ((btab && far) ? cfar : 0.f) - mref[qb];
            f32x16 s;
#pragma unroll
            for (int r = 0; r < 16; ++r) s[r] = sinit;
#pragma unroll
            for (int d0 = 0; d0 < 4; ++d0) s = MFMA32(kf[d0], qf[qb][d0], s);
            if (btab && !far) { const LAS float* bp = btab + (relbase + qb * 32 + r32 - kb0 + 128);
#pragma unroll
                for (int r = 0; r < 16; ++r) s[r] += bp[-(16 * (r >> 3) + (r & 7))];
            }
            if (tail) {
#pragma unroll
                for (int r = 0; r < 16; ++r) if (kb0 + 16 * (r >> 3) + (r & 7) >= nkeys) s[r] = -1e30f;
            }
            float m0 = fmaxf(fmaxf(s[0], s[1]), s[2]), m1 = fmaxf(fmaxf(s[3], s[4]), s[5]);
            m0 = fmaxf(fmaxf(m0, s[6]), s[7]); m1 = fmaxf(fmaxf(m1, s[8]), s[9]); m0 = fmaxf(fmaxf(m0, s[10]), s[11]); m1 = fmaxf(fmaxf(m1, s[12]), s[13]); m0 = fmaxf(fmaxf(m0, s[14]), s[15]);
            const float mx = swapmax(fmaxf(m0, m1));
            if (btab && kb == 0) {
                mref[qb] = mx;
#pragma unroll
                for (int r = 0; r < 16; ++r) s[r] -= mx;
            } else if (__builtin_amdgcn_ballot_w64(mx > 8.0f) != 0ull) {
                const float dl = fmaxf(mx, 0.f), alpha = __builtin_amdgcn_exp2f(-dl);
                mref[qb] += dl; lrun[qb] *= alpha;
#pragma unroll
                for (int r = 0; r < 16; ++r) s[r] -= dl;
#pragma unroll
                for (int db = 0; db < 2; ++db)
#pragma unroll
                    for (int r = 0; r < 16; ++r) o[qb][db][r] *= alpha;
            }
            float ps0 = 0.f, ps1 = 0.f;
#pragma unroll
            for (int r = 0; r < 16; r += 2) { s[r] = __builtin_amdgcn_exp2f(s[r]); s[r + 1] = __builtin_amdgcn_exp2f(s[r + 1]); ps0 += s[r]; ps1 += s[r + 1]; }
            lrun[qb] += ps0 + ps1;
            u32x4 p0, p1;
            p0.x = cvt_pk_bf16(s[0], s[1]); p0.y = cvt_pk_bf16(s[2], s[3]); p0.z = cvt_pk_bf16(s[4], s[5]); p0.w = cvt_pk_bf16(s[6], s[7]);
            p1.x = cvt_pk_bf16(s[8], s[9]); p1.y = cvt_pk_bf16(s[10], s[11]); p1.z = cvt_pk_bf16(s[12], s[13]); p1.w = cvt_pk_bf16(s[14], s[15]);
            const bf16x8 pf0 = __builtin_bit_cast(bf16x8, p0), pf1 = __builtin_bit_cast(bf16x8, p1);
#pragma unroll
            for (int db = 0; db < 2; ++db) {
                o[qb][db] = MFMA32(vf[db][0], pf0, o[qb][db]);
                o[qb][db] = MFMA32(vf[db][1], pf1, o[qb][db]);
            }
        }
#pragma unroll
        for (int d0 = 0; d0 < 4; ++d0) kf[d0] = kn[d0];
#pragma unroll
        for (int db = 0; db < 2; ++db)
#pragma unroll
            for (int ks = 0; ks < 2; ++ks) vf[db][ks] = vn[db][ks];
    }
#pragma unroll
    for (int qb = 0; qb < 2; ++qb) {
        const float inv = 1.0f / swapsum(lrun[qb]); float ss = 0.f;
        LAS unsigned char* rowp = otile + (qb * 32 + r32) * OT_STRIDE + (ocol + 4 * hi) * 2;
#pragma unroll
        for (int db = 0; db < 2; ++db)
#pragma unroll
            for (int g = 0; g < 4; ++g) { const float v0 = o[qb][db][4 * g] * inv, v1 = o[qb][db][4 * g + 1] * inv, v2 = o[qb][db][4 * g + 2] * inv, v3 = o[qb][db][4 * g + 3] * inv;
                ss += (v0 * v0 + v1 * v1) + (v2 * v2 + v3 * v3);
                u32x2 w; w.x = cvt_pk_bf16(v0, v1); w.y = cvt_pk_bf16(v2, v3);
                *(LAS u32x2*)(rowp + (db * 32 + 8 * g) * 2) = w; }
        ss = swapsum(ss);
        if (qb == 0) ssq0 += ss; else ssq1 += ss;
    }
}

constexpr int N_ATT_UNITS = 512 + 8 + 512 + 8;
__device__ __forceinline__ void attn_phase(const Args& a, LAS unsigned char* lds, int tid, int wave, int lane) {
    unsigned char* ws = a.ws;
    const bf16_t* QA = (const bf16_t*)(ws + WS_QA); const bf16_t* QB = (const bf16_t*)(ws + WS_QB); const bf16_t* KPA = (const bf16_t*)(ws + WS_KPA); const bf16_t* KPB = (const bf16_t*)(ws + WS_KPB);
    const bf16_t* KSA = (const bf16_t*)(ws + WS_KSA); const bf16_t* KSB = (const bf16_t*)(ws + WS_KSB); const bf16_t* VTA = (const bf16_t*)(ws + WS_VTA); const bf16_t* VTB = (const bf16_t*)(ws + WS_VTB);
    const bf16_t* VTSA = (const bf16_t*)(ws + WS_VTSA); const bf16_t* VTSB = (const bf16_t*)(ws + WS_VTSB);
    bf16_t* O = (bf16_t*)(ws + WS_O);
    unsigned* counter = (unsigned*)(ws + WS_CTL);
    LAS unsigned* lctl = (LAS unsigned*)(lds + L_CTL);
    LAS float* lssq = (LAS float*)(lds + L_SSQ);
    LAS float* btab = (LAS float*)(lds + L_BIAS + wave * 1408);
    LAS unsigned char* otile = lds + L_OT;
    for (;;) {
        if (tid == 0) lctl[0] = atomicAdd(counter, 1u);
        __syncthreads();
        const int u = (int)lctl[0];
        if (u >= N_ATT_UNITS) break;
        int grp, b, c = 0; bool samp;
        if (u < 512) { grp = 0; samp = false; b = u >> 6; c = 63 - (u & 63); }
        else if (u < 520) { grp = 0; samp = true; b = u - 512; }
        else if (u < 1032) { grp = 1; samp = false; b = (u - 520) >> 6; c = 63 - ((u - 520) & 63); }
        else { grp = 1; samp = true; b = u - 1032; }
        float ssq0 = 0.f, ssq1 = 0.f;
        for (int hh = 0; hh < 2; ++hh) {
            const int head = 2 * wave + hh;
            const bf16_t* Qp; const unsigned char *Kt, *Vt; int nkeys, relbase; const LAS float* bt; float mi, li;
            if (grp == 0) {
                for (int i = lane; i < 352; i += 64) btab[i] = a.in[I_REL][head * 257 + min(i, 256)] * LOG2E;
                bt = btab; mi = 0.f; li = 0.f;
                if (!samp) { const int c0 = max(c - 8, 0); const size_t to = ((size_t)(b * 16 + head) * 128 + 2 * c0) * 4096;
                    Qp = QA + ((size_t)(b * 64 + c) * 16 + head) * 4096; Kt = (const unsigned char*)KPA + to; Vt = (const unsigned char*)VTA + to; nkeys = (c - c0 + 1) * 64; relbase = (c - c0) * 64;
                } else { const size_t to = (size_t)(b * 16 + head) * 17 * 4096;
                    Qp = QA + (size_t)(MP + b * 16) * 1024 + head * 64; Kt = (const unsigned char*)KSA + to; Vt = (const unsigned char*)VTSA + to; nkeys = 528; relbase = 512;
                }
            } else {
                const int kvh = head >> 3; bt = nullptr; mi = a.in[I_SINK][head] * LOG2E; li = 1.f; relbase = 0;
                if (!samp) { const int c0 = max(c - 2, 0); const size_t to = ((size_t)(b * 2 + kvh) * 128 + 2 * c0) * 4096;
                    Qp = QB + ((size_t)(b * 64 + c) * 16 + head) * 4096; Kt = (const unsigned char*)KPB + to; Vt = (const unsigned char*)VTB + to; nkeys = (c - c0 + 1) * 64;
                } else { const size_t to = (size_t)(b * 2 + kvh) * 5 * 4096;
                    Qp = QB + (size_t)(MP + b * 16) * 1024 + head * 64; Kt = (const unsigned char*)KSB + to; Vt = (const unsigned char*)VTSB + to; nkeys = 144;
                }
            }
            attn_head(Qp, Kt, Vt, nkeys, relbase, bt, mi, li, otile, head * 64, ssq0, ssq1, lane, !samp);
        }
        if (lane < 32) { lssq[wave * 64 + lane] = ssq0; lssq[wave * 64 + 32 + lane] = ssq1; }
        __syncthreads();
        const int nvalid = samp ? 16 : 64; const size_t grow0 = samp ? (size_t)(MP + b * 16) : (size_t)(b * 4096 + c * 64);
        for (int i = 0; i < 8; ++i) { const int row = wave * 8 + i; if (row >= nvalid) break;
            float t = 0.f;
#pragma unroll
            for (int w = 0; w < 8; ++w) t += lssq[w * 64 + row];
            const float rn = 1.0f / sqrtf(t * (1.f / 1024.f) + EPS);
#pragma unroll
            for (int j = 0; j < 2; ++j) { const int ch = lane + 64 * j; const u32x4 w = *(const LAS u32x4*)(otile + row * OT_STRIDE + ch * 16); u32x4 r;
#pragma unroll
                for (int e = 0; e < 4; ++e) { const float lo = __uint_as_float(w[e] << 16) * rn, hi_ = __uint_as_float(w[e] & 0xffff0000u) * rn; r[e] = cvt_pk_bf16(lo, hi_); }
                *(u32x4*)(O + (grow0 + row) * DM + grp * 1024 + ch * 8) = r; } }
        __syncthreads();
    }
}

#define XB_TMO      128
#define XB_XCNT(j)  (256  + 64 * (j))
#define XB_XSUB(j)  (1280 + 64 * (j))
#define XB_XGEN(j)  (2304 + 64 * (j))
#define XB_TOP      3328
#define XB_TOPGEN   3392
#define XCD_BAR_WORDS 3456
#define XB_SPIN_CAP (1u << 18)

__device__ __forceinline__ unsigned xb_ld(unsigned* p)              { return __hip_atomic_load(p, __ATOMIC_RELAXED, __HIP_MEMORY_SCOPE_AGENT); }
__device__ __forceinline__ unsigned xb_add(unsigned* p, unsigned v) { return __hip_atomic_fetch_add(p, v, __ATOMIC_RELAXED, __HIP_MEMORY_SCOPE_AGENT); }
__device__ __forceinline__ unsigned xb_xcc_id() { return (unsigned)__builtin_amdgcn_s_getreg((3 << 11) | 20) & 0xFu; }
#define XB_SPIN(cond, bar) do { unsigned _sp = 0; while (cond) { __builtin_amdgcn_s_sleep(1); \
    if ((++_sp & 255u) == 0u) { if (xb_ld(&(bar)[XB_TMO])) break; if (_sp > XB_SPIN_CAP) { atomicAdd(&(bar)[XB_TMO], 1u); break; } } } } while (0)

struct XcdBarrier {
    unsigned* bar; unsigned x;
    volatile LAS unsigned* st;
};

__device__ __forceinline__ XcdBarrier xcd_barrier_post(unsigned* bar, volatile LAS unsigned* st) {
    XcdBarrier b; b.bar = bar; b.x = xb_xcc_id(); b.st = st;
    if (threadIdx.x == 0) (void)xb_add(&bar[XB_XCNT(b.x)], 1u);
    return b;
}
__device__ __forceinline__ void xcd_barrier_complete(unsigned* bar, unsigned x, unsigned& nloc, unsigned& nx) {
    const unsigned G = gridDim.x * gridDim.y * gridDim.z;
    unsigned sum, cnt, mine, sp = 0u;
    for (;;) {
        sum = 0u; cnt = 0u; mine = 0u;
#pragma unroll
        for (unsigned j = 0; j < 16; ++j) { const unsigned c = xb_ld(&bar[XB_XCNT(j)]); sum += c; cnt += (c > 0u) ? 1u : 0u; mine = (j == x) ? c : mine; }
        if (sum == G) break;
        __builtin_amdgcn_s_sleep(1);
        if ((++sp & 255u) == 0u) { if (xb_ld(&bar[XB_TMO])) break; if (sp > XB_SPIN_CAP) { atomicAdd(&bar[XB_TMO], 1u); break; } }
    }
    nloc = mine > 0u ? mine : 1u; nx = cnt > 0u ? cnt : 1u;
}

__device__ __forceinline__ void xcd_barrier(const XcdBarrier& b) {
    asm volatile("s_waitcnt vmcnt(0)" ::: "memory");
    __syncthreads();
    if (threadIdx.x == 0) {
        unsigned* bar = b.bar;
        __builtin_amdgcn_s_waitcnt(0);
        unsigned nloc = b.st[0], nx = b.st[1];
        if (nloc == 0u) { xcd_barrier_complete(bar, b.x, nloc, nx); b.st[0] = nloc; b.st[1] = nx; }
        const unsigned old = xb_add(&bar[XB_XSUB(b.x)], 1u);
        const unsigned gen = old / nloc;
        if (old + 1u == (gen + 1u) * nloc) {
            __builtin_amdgcn_fence(__ATOMIC_RELEASE, "agent");
            asm volatile("s_waitcnt vmcnt(0)" ::: "memory");
            const unsigned og = xb_add(&bar[XB_TOP], 1u);
            const unsigned tg = og / nx;
            if (og + 1u == (tg + 1u) * nx) xb_add(&bar[XB_TOPGEN], 1u);
            else XB_SPIN(xb_ld(&bar[XB_TOPGEN]) == tg, bar);
            __builtin_amdgcn_fence(__ATOMIC_ACQUIRE, "agent");
            xb_add(&bar[XB_XGEN(b.x)], 1u);
            asm volatile("s_waitcnt vmcnt(0)" ::: "memory");
        } else {
            XB_SPIN(xb_ld(&bar[XB_XGEN(b.x)]) == gen, bar);
            __builtin_amdgcn_fence(__ATOMIC_ACQUIRE, "agent");
            asm volatile("s_waitcnt vmcnt(0)" ::: "memory");
        }
    }
    __syncthreads();
}

__global__ void __launch_bounds__(512, 2) hymba_fwd(Args a) {
    extern __shared__ __attribute__((aligned(16))) unsigned char lds_raw[];
    cg::grid_group grid = cg::this_grid();
    LAS unsigned char* lds = (LAS unsigned char*)lds_raw;
    const int tid = threadIdx.x, lane = tid & 63, wave = __builtin_amdgcn_readfirstlane(tid >> 6);
    const int G = gridDim.x, bx = blockIdx.x;
    unsigned char* ws = a.ws;
    float* ssq1 = (float*)(ws + WS_SSQ1); float* ssq2 = (float*)(ws + WS_SSQ2);
    if (tid < 16) ((LAS unsigned*)(lds + L_CTL))[tid] = 0u;
    __syncthreads();
    bf16_t* XN = (bf16_t*)(ws + WS_XN); bf16_t* O = (bf16_t*)(ws + WS_O); bf16_t* X1B = (bf16_t*)(ws + WS_X1B); bf16_t* ACT = (bf16_t*)(ws + WS_ACT);

#ifndef NO_P0
    p0_prologue(a, lds, bx, G, wave, lane);
#endif
    grid.sync();
    const XcdBarrier bar = xcd_barrier_post((unsigned*)(ws + WS_BAR), (volatile LAS unsigned*)(lds + L_CTL) + 8);
#ifndef NO_P1
    {
        pg8::Gemm g{XN, (const bf16_t*)(ws + WS_WIN), MPAD, DIN, DM, DM}; pg8::StaticOrder S; S.init(MPAD, DIN, G, bx);
        EpiIn E{(bf16_t*)(ws + WS_QA), (bf16_t*)(ws + WS_QB), (bf16_t*)(ws + WS_KPA), (bf16_t*)(ws + WS_KSA), (bf16_t*)(ws + WS_KPB), (bf16_t*)(ws + WS_KSB),
                (bf16_t*)(ws + WS_VTA), (bf16_t*)(ws + WS_VTSA), (bf16_t*)(ws + WS_VTB), (bf16_t*)(ws + WS_VTSB), a.out};
        pg8::gemm_phase<EpiIn, pg8::StaticOrder, true, true>(lds, g, S, E);
    }
#endif
    xcd_barrier(bar);
#ifndef NO_P2
    { int t2 = threadIdx.x; asm volatile("" : "+v"(t2)); attn_phase(a, lds, t2, __builtin_amdgcn_readfirstlane(t2 >> 6), t2 & 63); }
#endif
    xcd_barrier(bar);
#ifndef NO_P3
    {
        pg8::Gemm g{O, (const bf16_t*)(ws + WS_WOUT), MP, DM, DM, DM}; pg8::StaticOrder S; S.init(MP, DM, G, bx);
        EpiOut E{XN, (const float*)(ws + WS_SSQ2), X1B, ssq1};
        pg8::gemm_phase<EpiOut, pg8::StaticOrder, true, true>(lds, g, S, E);
        pg8::Gemm g2{O, (const bf16_t*)(ws + WS_WOUT), MPAD, DM, DM, 256}; SplitKOrder S2{128, DM / 256, DM / 256, 256, G, bx};
        EpiAtomic E2{a.out};
        pg8::gemm_phase<EpiAtomic, SplitKOrder, true, true>(lds, g2, S2, E2);
    }
#endif
    xcd_barrier(bar);
#ifndef NO_P4
    {
        if (bx < NGU / 256) {
            for (int i = 0; i < 16; ++i) { const int m = MP + wave * 16 + i; const f32x4* xr = (const f32x4*)(a.out + (size_t)m * DM) + lane; f32x4 v[8]; float s = 0.f;
#pragma unroll
                for (int j = 0; j < 8; ++j) { v[j] = xr[64 * j]; s += (v[j].x * v[j].x + v[j].y * v[j].y) + (v[j].z * v[j].z + v[j].w * v[j].w); }
                s = wave_sum(s); if (lane == 0) ssq1[m] = s;
                u32x2* o8 = (u32x2*)(X1B + (size_t)m * DM) + lane;
#pragma unroll
                for (int j = 0; j < 8; ++j) { u32x2 w; w.x = cvt_pk_bf16(v[j].x, v[j].y); w.y = cvt_pk_bf16(v[j].z, v[j].w); o8[64 * j] = w; } }
            asm volatile("s_waitcnt vmcnt(0)" ::: "memory"); __syncthreads();
        }
        pg8::Gemm g{X1B, (const bf16_t*)(ws + WS_WGU), MP, NGU, DM, DM}; pg8::StaticOrder S; S.init(MP, NGU, G, bx);
        EpiGU E{ACT, ssq1};
        pg8::gemm_phase<EpiGU, pg8::StaticOrder, true, true>(lds, g, S, E);
        SplitKOrder S2{128, NGU / 256, 1, 0, G, bx};
        pg8::gemm_phase<EpiGU, SplitKOrder, true, true, true>(lds, g, S2, E);
    }
#endif
    xcd_barrier(bar);
#ifndef NO_P5
    {
        pg8::Gemm g{ACT, (const bf16_t*)(ws + WS_WD), MP, DM, DFF, DFF}; pg8::StaticOrder S; S.init(MP, DM, G, bx);
        EpiDown E{X1B};
        pg8::gemm_phase<EpiDown, pg8::StaticOrder, true, true>(lds, g, S, E);
        pg8::Gemm g2{ACT, (const bf16_t*)(ws + WS_WD), MPAD, DM, DFF, 256}; SplitKOrder S2{128, DM / 256, DFF / 256, 256, G, bx};
        EpiAtomic E2{a.out};
        pg8::gemm_phase<EpiAtomic, SplitKOrder, true, true>(lds, g2, S2, E2);
    }
#endif
    xcd_barrier(bar);
    {
        const float* gf = a.in[I_NFIN];
        const int gw = bx * 8 + wave, NGW = G * 8;
        for (int m0 = gw; m0 < MP; m0 += 4 * NGW) {
            u32x4 w[4][4];
#pragma unroll
            for (int rr = 0; rr < 4; ++rr) { const int m = min(m0 + rr * NGW, MP - 1); const u32x4* xr = (const u32x4*)(X1B + (size_t)m * DM) + lane;
#pragma unroll
                for (int j = 0; j < 4; ++j) w[rr][j] = xr[64 * j]; }
#pragma unroll
            for (int rr = 0; rr < 4; ++rr) { const int m = m0 + rr * NGW; if (m >= MP) break;
                f32x4 v[4][2]; float s = 0.f;
#pragma unroll
                for (int j = 0; j < 4; ++j) { v[j][0] = (f32x4){__uint_as_float(w[rr][j].x << 16), __uint_as_float(w[rr][j].x & 0xffff0000u), __uint_as_float(w[rr][j].y << 16), __uint_as_float(w[rr][j].y & 0xffff0000u)};
                    v[j][1] = (f32x4){__uint_as_float(w[rr][j].z << 16), __uint_as_float(w[rr][j].z & 0xffff0000u), __uint_as_float(w[rr][j].w << 16), __uint_as_float(w[rr][j].w & 0xffff0000u)};
#pragma unroll
                    for (int h = 0; h < 2; ++h) s += (v[j][h].x * v[j][h].x + v[j][h].y * v[j][h].y) + (v[j][h].z * v[j][h].z + v[j][h].w * v[j][h].w); }
                const float r = __builtin_amdgcn_rsqf(wave_sum(s) * (1.f / DM) + EPS);
                f32x4* yo = (f32x4*)(a.out + (size_t)m * DM);
#pragma unroll
                for (int j = 0; j < 4; ++j)
#pragma unroll
                    for (int h = 0; h < 2; ++h) { const int q = 2 * (lane + 64 * j) + h; yo[q] = v[j][h] * r * ((const f32x4*)gf)[q]; } }
        }
        for (int m = MP + gw; m < MV; m += NGW) {
            f32x4* xr = (f32x4*)(a.out + (size_t)m * DM) + lane; f32x4 v[8]; float s = 0.f;
#pragma unroll
            for (int j = 0; j < 8; ++j) { v[j] = xr[64 * j]; s += (v[j].x * v[j].x + v[j].y * v[j].y) + (v[j].z * v[j].z + v[j].w * v[j].w); }
            const float r = 1.0f / sqrtf(wave_sum(s) * (1.f / DM) + EPS);
#pragma unroll
            for (int j = 0; j < 8; ++j) { const f32x4 gv = ((const f32x4*)gf)[lane + 64 * j]; xr[64 * j] = v[j] * r * gv; }
        }
    }
}

extern "C" void kernel_launch(void* const* d_in, const int* in_sizes, int n_in, void* d_out, int out_size, void* d_ws, size_t ws_size, hipStream_t stream) {
    static int grid = 0;
    if (grid == 0) {
        if (n_in != 18 || in_sizes[0] != MP * DM || (size_t)out_size != O_END || ws_size < WS_END) {
            fprintf(stderr, "kernel_launch: unexpected shapes: n_in %d in0 %d out %d ws %zu\n", n_in, n_in > 0 ? in_sizes[0] : -1, out_size, ws_size); grid = -1; return; }
        int dev = 0, cus = 0, per_cu = 0;
        (void)hipGetDevice(&dev); (void)hipDeviceGetAttribute(&cus, hipDeviceAttributeMultiprocessorCount, dev);
        if (hipFuncSetAttribute((const void*)hymba_fwd, hipFuncAttributeMaxDynamicSharedMemorySize, LDS_BYTES) != hipSuccess) { fprintf(stderr, "kernel_launch: hipFuncSetAttribute failed\n"); }
        if (hipOccupancyMaxActiveBlocksPerMultiprocessor(&per_cu, (const void*)hymba_fwd, 512, LDS_BYTES) != hipSuccess || per_cu < 1) { fprintf(stderr, "kernel_launch: occupancy query says %d\n", per_cu); per_cu = 1; }
        (void)hipGetLastError();
        grid = cus * per_cu;
    }
    if (grid < 0) return;
    Args a{};
    for (int i = 0; i < 18; ++i) a.in[i] = (const float*)d_in[i];
    a.out = (float*)d_out; a.ws = (unsigned char*)d_ws;
    void* args[] = {&a};
    hipError_t e = hipLaunchCooperativeKernel((const void*)hymba_fwd, dim3(grid), dim3(512), args, LDS_BYTES, stream);
    if (e != hipSuccess) fprintf(stderr, "cooperative launch failed: %s (grid %d)\n", hipGetErrorString(e), grid);
}
```

```cpp
#include <hip/hip_runtime.h>
#include <hip/hip_cooperative_groups.h>
#include <cstdio>
#include <cstdint>
namespace cg = cooperative_groups;
namespace pg8 {
#define PG8_LAS __attribute__((address_space(3)))
typedef unsigned short bf16_t;
typedef short bf16x8 __attribute__((ext_vector_type(8)));
typedef float f32x4 __attribute__((ext_vector_type(4)));
typedef unsigned u32x4 __attribute__((ext_vector_type(4)));
constexpr int BM = 256, BK = 64, HALF = 128, HTB = HALF * BK * 2  , STAGE_BYTES = 8 * HTB, NXCD = 8, WGM = 8;

__host__ __device__ __forceinline__ int lds_byte(int r, int c) { const int st = (r >> 4) * 2 + (c >> 5), rr = r & 15, cc = c & 31, ob = rr * 64 + cc * 2; return st * 1024 + (ob ^ (((ob >> 9) & 1) << 5)); }
__host__ __device__ __forceinline__ void stage_rc(int b, int& R, int& C) { const int st = b / 1024, sb = b % 1024, swz = sb ^ (((sb >> 9) & 1) << 5); R = (st >> 1) * 16 + swz / 64; C = (st & 1) * 32 + (swz % 64) / 2; }
__host__ __device__ __forceinline__ int perm32(int rho) { const int n = rho >> 4, i = rho & 15; return 8 * (i >> 2) + 4 * n + (i & 3); }

struct Unit { int pm, pn, k0; };
struct Gemm { const bf16_t* A; const bf16_t* Bt; int M, N, K, KL; };

struct StaticOrder {
    int nM, nN, nwg, G, c;
    __host__ __device__ void init(int M, int N, int G_, int c_) { nM = M / BM; nN = N / BM; nwg = nM * nN; G = G_; c = c_; }
    __host__ __device__ bool next(int i, Unit& u) const {
        const long L = (long)i * G + c; if (L >= nwg) return false;
        int wgid = (int)L; { const int q = nwg / NXCD, r = nwg % NXCD, xcd = wgid % NXCD, off = wgid / NXCD; wgid = (xcd < r ? xcd * (q + 1) : r * (q + 1) + (xcd - r) * q) + off; }
        const int nig = WGM * nN, gid = wgid / nig, fm = gid * WGM, gsz = (nM - fm) < WGM ? (nM - fm) : WGM;
        u.pm = fm + ((wgid % nig) % gsz); u.pn = (wgid % nig) / gsz; u.k0 = 0; return true;
    }
    __device__ __forceinline__ void a_ready(const Unit&) const {}
    __device__ __forceinline__ void done(const Unit&) const {}
};
__device__ __forceinline__ unsigned cvt_pk_bf16(float lo, float hi) { unsigned r; asm volatile("v_cvt_pk_bf16_f32 %0, %1, %2" : "=v"(r) : "v"(lo), "v"(hi)); return r; }
typedef float f32x2 __attribute__((ext_vector_type(2)));
template <class Epi, class Sched, bool ALIGN_EPI = false, bool SP2 = false, bool HALFM = false  >
__device__ __forceinline__ void gemm_phase(PG8_LAS unsigned char* lds, const Gemm g, const Sched& S, const Epi& E) {
    int tid_l = threadIdx.x; asm volatile("" : "+v"(tid_l));
    const int tid = tid_l, wid = __builtin_amdgcn_readfirstlane(tid >> 6), lane = tid & 63, wr = wid >> 2, wc = wid & 3, fr = lane & 15, fq = lane >> 4;
    const int K = g.K, nt = g.KL / BK;
    unsigned voffA[2], voffB[2];
#pragma unroll
    for (int i = 0; i < 2; ++i) { int R, C; stage_rc(tid * 16 + i * 8192, R, C); const int Rb = Epi::PERM ? ((R & ~31) + perm32(R & 31)) : R;
        voffA[i] = (unsigned)(R * K + C) * 2u; voffB[i] = (unsigned)(Rb * K + C) * 2u; }
    const size_t kstep = (size_t)(BK * 2);
    const size_t hstep = (size_t)HALF * K * 2;
    const size_t tstep = 2 * hstep;
    const unsigned ldsw = (unsigned)wid * 1024u;
    const int aoff = lds_byte(wr * 64 + fr, fq * 8), boff = lds_byte(wc * 32 + fr, fq * 8);
#define PG8_SA(b, h) (((b) * 2 + (h)) * HTB)
#define PG8_SB(b, h) ((4 + (b) * 2 + (h)) * HTB)
#define PG8_STAGE(bufoff, gbase, voff) do { _Pragma("unroll") for (int _i = 0; _i < 2; ++_i) \
        __builtin_amdgcn_global_load_lds((const unsigned*)((const char*)(gbase) + (voff)[_i]), (PG8_LAS unsigned*)(lds + (bufoff) + ldsw + _i * 8192), 16, 0, 0); } while (0)
#define PG8_LDA(dst, b, h) do { _Pragma("unroll") for (int m = 0; m < 4; ++m) _Pragma("unroll") for (int k = 0; k < 2; ++k) dst[m][k] = *(const PG8_LAS bf16x8*)(lds + PG8_SA(b, h) + aoff + m * 2048 + k * 1024); } while (0)
#define PG8_LDB(dst, b, h) do { _Pragma("unroll") for (int n = 0; n < 2; ++n) _Pragma("unroll") for (int k = 0; k < 2; ++k) dst[n][k] = *(const PG8_LAS bf16x8*)(lds + PG8_SB(b, h) + boff + n * 2048 + k * 1024); } while (0)
#define PG8_MMA(ai, bj, At, Bt) do { __builtin_amdgcn_s_setprio(1); _Pragma("unroll") for (int m = 0; m < 4; ++m) _Pragma("unroll") for (int n = 0; n < 2; ++n) _Pragma("unroll") for (int k = 0; k < 2; ++k) \
        acc[ai][bj][m][n] = __builtin_amdgcn_mfma_f32_16x16x32_bf16(Bt[n][k], At[m][k], acc[ai][bj][m][n], 0, 0, 0); __builtin_amdgcn_s_setprio(0); } while (0)
#define PG8_WAIT_V(n) asm volatile("s_waitcnt vmcnt(" #n ")" ::: "memory")
#define PG8_WAIT_L(n) asm volatile("s_waitcnt lgkmcnt(" #n ")" ::: "memory")
#define PG8_BAR __builtin_amdgcn_s_barrier()
#define PG8_SCHED __builtin_amdgcn_sched_barrier(0)
    Unit cur, nxt; int ui = 0;
    if (!S.next(0, cur)) return;
    f32x4 acc[2][2][4][2];
#pragma unroll
    for (int a = 0; a < 2; ++a)
#pragma unroll
        for (int b = 0; b < 2; ++b)
#pragma unroll
            for (int m = 0; m < 4; ++m)
#pragma unroll
                for (int n = 0; n < 2; ++n) acc[a][b][m][n] = (f32x4){0.f, 0.f, 0.f, 0.f};
    bf16x8 At[4][2], B0[2][2], B1[2][2];
    const char* cA = (const char*)g.A + (size_t)cur.pm * tstep + (size_t)cur.k0 * 2; const char* cB = (const char*)g.Bt + (size_t)cur.pn * tstep + (size_t)cur.k0 * 2;
    S.a_ready(cur);
    if constexpr (SP2) {
        PG8_STAGE(PG8_SB(0, 0), cB, voffB); PG8_STAGE(PG8_SB(0, 1), cB + hstep, voffB); PG8_STAGE(PG8_SA(0, 0), cA, voffA); PG8_STAGE(PG8_SA(0, 1), cA + hstep, voffA);
        if (wr == 1) PG8_BAR;
        PG8_WAIT_V(2); PG8_BAR;
        PG8_STAGE(PG8_SB(1, 0), cB + kstep, voffB); PG8_STAGE(PG8_SA(1, 0), cA + kstep, voffA); PG8_STAGE(PG8_SB(1, 1), cB + hstep + kstep, voffB);
        PG8_WAIT_V(6); PG8_BAR;
    } else {
        PG8_STAGE(PG8_SB(0, 0), cB, voffB); PG8_STAGE(PG8_SA(0, 0), cA, voffA); PG8_STAGE(PG8_SB(0, 1), cB + hstep, voffB); PG8_STAGE(PG8_SA(0, 1), cA + hstep, voffA);
        if (wr == 1) PG8_BAR;
        PG8_WAIT_V(4); PG8_BAR;
        PG8_STAGE(PG8_SB(1, 0), cB + kstep, voffB); PG8_STAGE(PG8_SA(1, 0), cA + kstep, voffA); PG8_STAGE(PG8_SB(1, 1), cB + hstep + kstep, voffB);
        PG8_WAIT_V(6); PG8_BAR;
    }
    for (;;) {
        const bool has_next = S.next(ui + 1, nxt);
        const char* nA = has_next ? (const char*)g.A + (size_t)nxt.pm * tstep + (size_t)nxt.k0 * 2 : cA; const char* nB = has_next ? (const char*)g.Bt + (size_t)nxt.pn * tstep + (size_t)nxt.k0 * 2 : cB;
        for (int t = 0; t < nt; t += 2) {
            const bool last = (t == nt - 2);
            const char* a1 = cA + (size_t)(t + 1) * kstep;
            const char* a2 = last ? nA : cA + (size_t)(t + 2) * kstep; const char* b2 = last ? nB : cB + (size_t)(t + 2) * kstep;
            const char* a3 = a2 + kstep; const char* b3 = b2 + kstep;
            if (last && has_next) S.a_ready(nxt);
            if constexpr (SP2) {
            PG8_LDB(B0, 0, 0); PG8_LDB(B1, 0, 1); PG8_SCHED; PG8_LDA(At, 0, 0); PG8_STAGE(PG8_SA(1, 1), a1 + hstep, voffA);
            PG8_WAIT_V(8); PG8_WAIT_L(0); PG8_BAR; PG8_MMA(0, 0, At, B0); PG8_MMA(0, 1, At, B1); PG8_BAR; PG8_SCHED;
            if constexpr (!HALFM) { PG8_LDA(At, 0, 1); } PG8_STAGE(PG8_SB(0, 0), b2, voffB); PG8_STAGE(PG8_SB(0, 1), b2 + hstep, voffB); PG8_STAGE(PG8_SA(0, 0), a2, voffA);
            PG8_WAIT_V(8); PG8_WAIT_L(0); PG8_BAR; if constexpr (!HALFM) { PG8_MMA(1, 0, At, B0); PG8_MMA(1, 1, At, B1); } PG8_BAR; PG8_SCHED;
            PG8_LDB(B0, 1, 0); PG8_LDB(B1, 1, 1); PG8_SCHED; PG8_LDA(At, 1, 0); PG8_STAGE(PG8_SA(0, 1), a2 + hstep, voffA);
            PG8_WAIT_V(8); PG8_WAIT_L(0); PG8_BAR; PG8_MMA(0, 0, At, B0); PG8_MMA(0, 1, At, B1); PG8_BAR; PG8_SCHED;
            if constexpr (!HALFM) { PG8_LDA(At, 1, 1); } PG8_STAGE(PG8_SB(1, 0), b3, voffB); PG8_STAGE(PG8_SB(1, 1), b3 + hstep, voffB); PG8_STAGE(PG8_SA(1, 0), a3, voffA);
            PG8_WAIT_V(8); PG8_WAIT_L(0); PG8_BAR; if constexpr (!HALFM) { PG8_MMA(1, 0, At, B0); PG8_MMA(1, 1, At, B1); } PG8_BAR; PG8_SCHED;
            } else {
            PG8_LDB(B0, 0, 0); PG8_SCHED; PG8_LDA(At, 0, 0); PG8_STAGE(PG8_SA(1, 1), a1 + hstep, voffA);
            PG8_WAIT_L(8); PG8_BAR; PG8_WAIT_L(0); PG8_MMA(0, 0, At, B0); PG8_BAR; PG8_SCHED;
            PG8_LDB(B1, 0, 1); PG8_STAGE(PG8_SB(0, 0), b2, voffB);
            PG8_BAR; PG8_WAIT_L(0); PG8_MMA(0, 1, At, B1); PG8_BAR;
            PG8_LDA(At, 0, 1); PG8_STAGE(PG8_SA(0, 0), a2, voffA);
            PG8_BAR; PG8_WAIT_L(0); PG8_MMA(1, 0, At, B0); PG8_BAR; PG8_SCHED;
            PG8_STAGE(PG8_SB(0, 1), b2 + hstep, voffB);
            PG8_WAIT_V(6); PG8_BAR; PG8_MMA(1, 1, At, B1); PG8_BAR;
            PG8_LDB(B0, 1, 0); PG8_SCHED; PG8_LDA(At, 1, 0); PG8_STAGE(PG8_SA(0, 1), a2 + hstep, voffA);
            PG8_WAIT_L(8); PG8_BAR; PG8_WAIT_L(0); PG8_MMA(0, 0, At, B0); PG8_BAR; PG8_SCHED;
            PG8_LDB(B1, 1, 1); PG8_STAGE(PG8_SB(1, 0), b3, voffB);
            PG8_BAR; PG8_WAIT_L(0); PG8_MMA(0, 1, At, B1); PG8_BAR;
            PG8_LDA(At, 1, 1); PG8_STAGE(PG8_SA(1, 0), a3, voffA);
            PG8_BAR; PG8_WAIT_L(0); PG8_MMA(1, 0, At, B0); PG8_BAR; PG8_SCHED;
            PG8_STAGE(PG8_SB(1, 1), b3 + hstep, voffB);
            PG8_WAIT_V(6); PG8_BAR; PG8_MMA(1, 1, At, B1); PG8_BAR;
            }
        }
        if constexpr (ALIGN_EPI) { if (wr == 0) PG8_BAR; }
        if constexpr (!Epi::AFTER_DRAIN) { E(acc, cur, wr, wc, fr, fq); S.done(cur); }
        if (!has_next) break;
#pragma unroll
        for (int a = 0; a < 2; ++a)
#pragma unroll
            for (int b = 0; b < 2; ++b)
#pragma unroll
                for (int m = 0; m < 4; ++m)
#pragma unroll
                    for (int n = 0; n < 2; ++n) acc[a][b][m][n] = (f32x4){0.f, 0.f, 0.f, 0.f};
        cur = nxt; cA = nA; cB = nB; ++ui;
        if constexpr (ALIGN_EPI) { if (wr == 1) PG8_BAR; }
    }
    PG8_WAIT_V(0);
    if constexpr (!ALIGN_EPI) { if (wr == 0) PG8_BAR; }
    PG8_BAR;
    if constexpr (Epi::AFTER_DRAIN) { E.fused(acc, cur, wr, wc, fr, fq, lds, wid, lane); S.done(cur); }
#undef PG8_SA
#undef PG8_SB
#undef PG8_STAGE
#undef PG8_LDA
#undef PG8_LDB
#undef PG8_MMA
#undef PG8_WAIT_V
#undef PG8_WAIT_L
#undef PG8_BAR
#undef PG8_SCHED
}
}

#define LAS __attribute__((address_space(3)))
typedef unsigned short bf16_t;
typedef short bf16x8 __attribute__((ext_vector_type(8)));
typedef float f32x4 __attribute__((ext_vector_type(4)));
typedef float f32x16 __attribute__((ext_vector_type(16)));
typedef unsigned u32x4 __attribute__((ext_vector_type(4)));
typedef unsigned u32x2 __attribute__((ext_vector_type(2)));
using pg8::cvt_pk_bf16;

constexpr int DM = 2048, SEQ = 4096, NB = 8, MP = NB * SEQ, MS = 128, MV = MP + MS, MPAD = 33024;
constexpr int DIN = 4352, DFF = 5632, NGU = 2 * DFF;
constexpr int SKA = 544, SKB = 160;
constexpr float EPS = 1e-6f, LOG2E = 1.4426950408889634f, QSCALE = 0.125f * LOG2E;
constexpr size_t O_AKP = (size_t)MV * DM, O_AVP = O_AKP + 8 * 512 * 1024, O_BKP = O_AVP + 8 * 512 * 1024, O_BVP = O_BKP + 8 * 128 * 128,
                 O_AKS = O_BVP + 8 * 128 * 128, O_AVS = O_AKS + 8 * 16 * 1024, O_BKS = O_AVS + 8 * 16 * 1024, O_BVS = O_BKS + 8 * 16 * 128, O_END = O_BVS + 8 * 16 * 128;
constexpr size_t MiB = 1u << 20;
constexpr size_t WS_CTL = 0, WS_SSQ1 = 64 * 1024, WS_SSQ2 = 256 * 1024, WS_BAR = 768 * 1024, BAR_BYTES = 16384;
constexpr size_t WS_WIN = 1 * MiB, WS_WOUT = 18 * MiB, WS_WGU = 26 * MiB, WS_WD = 70 * MiB, WS_KSA = 92 * MiB, WS_VTSA = 101 * MiB, WS_KSB = 110 * MiB, WS_VTSB = 111 * MiB,
                 WS_O = 112 * MiB, WS_X1B = 241 * MiB, WS_VTA = 370 * MiB, WS_VTB = 434 * MiB, WS_KPB = 442 * MiB,
                 WS_XN = 450 * MiB, WS_QA = 579 * MiB, WS_QB = 644 * MiB, WS_KPA = 709 * MiB, WS_ACT = 450 * MiB, WS_END = 805 * MiB;
static_assert(WS_WIN + (size_t)DIN * DM * 2 <= WS_WOUT && WS_WGU + (size_t)NGU * DM * 2 <= WS_WD && WS_WD + (size_t)DM * DFF * 2 <= WS_KSA, "ws map 1");
static_assert(WS_O + (size_t)MPAD * DM * 2 <= WS_X1B && WS_X1B + (size_t)MPAD * DM * 2 <= WS_VTA && WS_XN + (size_t)MPAD * DM * 2 <= WS_QA, "ws map 2");
static_assert(WS_QA + (size_t)MPAD * 1024 * 2 <= WS_QB && WS_QB + (size_t)MPAD * 1024 * 2 <= WS_KPA && WS_KPA + (size_t)MP * 1024 * 2 <= WS_END && WS_ACT + (size_t)MPAD * DFF * 2 <= WS_END, "ws map 3");
constexpr int LDS_BYTES = 147456, OT_STRIDE = 2064, L_OT = 0, L_SSQ = 64 * OT_STRIDE, L_BIAS = L_SSQ + 2048, L_CTL = L_BIAS + 8 * 1408;
static_assert(L_CTL + 64 <= LDS_BYTES, "lds map");

struct Args { const float* in[18]; float* out; unsigned char* ws; };
enum { I_XP = 0, I_XS, I_CAK, I_CAV, I_CBK, I_CBV, I_WIN, I_NMIX, I_REL, I_SINK, I_NGA, I_NGB, I_WOUT, I_NFFN, I_WG, I_WU, I_WD, I_NFIN };

#define LDS_WAIT() asm volatile("s_waitcnt lgkmcnt(0)" ::: "memory")
__device__ __forceinline__ float wave_sum(float v) {
#pragma unroll
    for (int o = 1; o < 64; o <<= 1) v += __shfl_xor(v, o);
    return v;
}
__device__ __forceinline__ u32x4 pack8(f32x4 a, f32x4 b) { u32x4 w; w.x = cvt_pk_bf16(a[0], a[1]); w.y = cvt_pk_bf16(a[2], a[3]); w.z = cvt_pk_bf16(b[0], b[1]); w.w = cvt_pk_bf16(b[2], b[3]); return w; }

__device__ __forceinline__ int pi32(int i) { return (i & ~12) | ((i & 4) << 1) | ((i & 8) >> 1); }
__device__ __forceinline__ void p0_transpose_item(const float* __restrict__ W, int K, int N, const float* __restrict__ g, const float* __restrict__ g2, bf16_t* WT, int mode, LAS float* scr, int item, int lane) {
    const int nblk = N / 64, kb = item / nblk, nb = item % nblk, k0 = 64 * kb, n0 = 64 * nb;
    const int kk = lane >> 4, cq = lane & 15;
    f32x4 v[16]; float sc[16];
#pragma unroll
    for (int i = 0; i < 16; ++i) { const int k = k0 + 4 * i + kk; v[i] = *(const f32x4*)(W + (size_t)k * N + n0 + 4 * cq); sc[i] = g ? ((g2 && k >= 1024) ? g2[k - 1024] : g[k]) : 1.f; }
#pragma unroll
    for (int i = 0; i < 16; ++i) { LAS float* d = scr + (4 * i + kk) * 65 + 4 * cq; d[0] = v[i].x * sc[i]; d[1] = v[i].y * sc[i]; d[2] = v[i].z * sc[i]; d[3] = v[i].w * sc[i]; }
    LDS_WAIT(); asm volatile("" ::: "memory");
    const int c = lane & 7;
    const int rowbase = (mode == 0) ? n0 : (256 * (n0 >> 7) + (n0 & 127) + (mode == 2 ? 128 : 0));
#pragma unroll
    for (int j = 0; j < 8; ++j) { const int n = (lane >> 3) + 8 * j; const LAS float* s_ = scr + (8 * c) * 65 + n;
        u32x4 o; o.x = cvt_pk_bf16(s_[0 * 65], s_[1 * 65]); o.y = cvt_pk_bf16(s_[2 * 65], s_[3 * 65]); o.z = cvt_pk_bf16(s_[4 * 65], s_[5 * 65]); o.w = cvt_pk_bf16(s_[6 * 65], s_[7 * 65]);
        *(u32x4*)(WT + (size_t)(rowbase + n) * K + k0 + 8 * c) = o; }
    LDS_WAIT(); asm volatile("" ::: "memory");
}

__device__ __forceinline__ void p0_prologue(const Args& a, LAS unsigned char* lds, int bx, int G, int wave, int lane) {
    unsigned char* ws = a.ws;
    if (wave < 4) {
        const int gw = bx * 4 + wave, NGW = G * 4;
        LAS float* scr = (LAS float*)(lds + wave * 16896);
        bf16_t* WIN = (bf16_t*)(ws + WS_WIN); bf16_t* WOUT = (bf16_t*)(ws + WS_WOUT); bf16_t* WGU = (bf16_t*)(ws + WS_WGU); bf16_t* WD = (bf16_t*)(ws + WS_WD);
        constexpr int IT_IN = (DM / 64) * (DIN / 64), IT_OUT = (DM / 64) * (DM / 64), IT_G = (DM / 64) * (DFF / 64), IT_D = (DFF / 64) * (DM / 64);
        constexpr int NITEMS = IT_IN + IT_OUT + 2 * IT_G + IT_D;
        for (int it = gw; it < NITEMS; it += NGW) {
            int r = it;
            if (r < IT_IN) { p0_transpose_item(a.in[I_WIN], DM, DIN, a.in[I_NMIX], nullptr, WIN, 0, scr, r, lane); continue; } r -= IT_IN;
            if (r < IT_OUT) { p0_transpose_item(a.in[I_WOUT], DM, DM, a.in[I_NGA], a.in[I_NGB], WOUT, 0, scr, r, lane); continue; } r -= IT_OUT;
            if (r < IT_G) { p0_transpose_item(a.in[I_WG], DM, DFF, a.in[I_NFFN], nullptr, WGU, 1, scr, r, lane); continue; } r -= IT_G;
            if (r < IT_G) { p0_transpose_item(a.in[I_WU], DM, DFF, a.in[I_NFFN], nullptr, WGU, 2, scr, r, lane); continue; } r -= IT_G;
            p0_transpose_item(a.in[I_WD], DFF, DM, nullptr, nullptr, WD, 0, scr, r, lane);
        }
        return;
    }
    const int gw = bx * 4 + (wave - 4), NGW = G * 4;
    bf16_t* XN = (bf16_t*)(ws + WS_XN); float* xscale = (float*)(ws + WS_SSQ2);
    for (int m0 = gw; m0 < MV; m0 += 2 * NGW) {
        const int m1 = m0 + NGW; const bool two = m1 < MV;
        const float* xrow0 = (m0 < MP) ? a.in[I_XP] + (size_t)m0 * DM : a.in[I_XS] + (size_t)(m0 - MP) * DM;
        const float* xrow1 = two ? ((m1 < MP) ? a.in[I_XP] + (size_t)m1 * DM : a.in[I_XS] + (size_t)(m1 - MP) * DM) : xrow0;
        const f32x4* xr0 = (const f32x4*)xrow0 + lane; const f32x4* xr1 = (const f32x4*)xrow1 + lane;
        f32x4 v0[8], v1[8]; float s0 = 0.f, s1 = 0.f;
#pragma unroll
        for (int j = 0; j < 8; ++j) { v0[j] = xr0[64 * j]; v1[j] = xr1[64 * j]; }
#pragma unroll
        for (int j = 0; j < 8; ++j) { s0 += (v0[j].x * v0[j].x + v0[j].y * v0[j].y) + (v0[j].z * v0[j].z + v0[j].w * v0[j].w); s1 += (v1[j].x * v1[j].x + v1[j].y * v1[j].y) + (v1[j].z * v1[j].z + v1[j].w * v1[j].w); }
        const float q0 = sqrtf(wave_sum(s0) * (1.f / DM) + EPS), q1 = sqrtf(wave_sum(s1) * (1.f / DM) + EPS), r0 = 1.0f / q0, r1 = 1.0f / q1;
        if (lane == 0) { xscale[m0] = q0; if (two) xscale[m1] = q1; }
        u32x2* o0 = (u32x2*)(XN + (size_t)m0 * DM) + lane;
#pragma unroll
        for (int j = 0; j < 8; ++j) { u32x2 w; w.x = cvt_pk_bf16(v0[j].x * r0, v0[j].y * r0); w.y = cvt_pk_bf16(v0[j].z * r0, v0[j].w * r0); o0[64 * j] = w; }
        if (two) { u32x2* o1 = (u32x2*)(XN + (size_t)m1 * DM) + lane;
#pragma unroll
            for (int j = 0; j < 8; ++j) { u32x2 w; w.x = cvt_pk_bf16(v1[j].x * r1, v1[j].y * r1); w.y = cvt_pk_bf16(v1[j].z * r1, v1[j].w * r1); o1[64 * j] = w; } }
    }
    const int gt = gw * 64 + lane, NGT = NGW * 64;
    unsigned char* KFSA = ws + WS_KSA; unsigned char* KFSB = ws + WS_KSB; unsigned char* VFSA = ws + WS_VTSA; unsigned char* VFSB = ws + WS_VTSB;
    for (int i = gt; i < 8 * SKA * 128; i += NGT) { const int ch = i & 127, s_ = (i >> 7) % SKA, b = (i >> 7) / SKA, head = ch >> 3, j = ch & 7;
        if (s_ >= 512 && s_ < 528) continue;
        u32x4 w = (u32x4){0u, 0u, 0u, 0u};
        if (s_ < 512) { const f32x4* src = (const f32x4*)(a.in[I_CAK] + ((size_t)(b * 512 + s_) * 1024 + ch * 8)); w = pack8(src[0], src[1]); }
        *(u32x4*)(KFSA + ((size_t)((b * 16 + head) * 17 + (s_ >> 5)) * 4096 + (j >> 1) * 1024 + ((j & 1) * 32 + pi32(s_ & 31)) * 16)) = w; }
    for (int i = gt; i < 8 * SKB * 16; i += NGT) { const int ch = i & 15, s_ = (i >> 4) % SKB, b = (i >> 4) / SKB, head = ch >> 3, j = ch & 7;
        if (s_ >= 128 && s_ < 144) continue;
        u32x4 w = (u32x4){0u, 0u, 0u, 0u};
        if (s_ < 128) { const f32x4* src = (const f32x4*)(a.in[I_CBK] + ((size_t)(b * 128 + s_) * 128 + ch * 8)); w = pack8(src[0], src[1]); }
        *(u32x4*)(KFSB + ((size_t)((b * 2 + head) * 5 + (s_ >> 5)) * 4096 + (j >> 1) * 1024 + ((j & 1) * 32 + pi32(s_ & 31)) * 16)) = w; }
    for (int it = gw; it < 8 * 16 * (SKA / 8); it += NGW) { const int sb = it % (SKA / 8), bh = it / (SKA / 8), b = bh >> 4, h = bh & 15, s0 = sb * 8;
        if (s0 >= 512 && s0 < 528) continue;
        u32x4 w = (u32x4){0u, 0u, 0u, 0u};
        if (s0 < 512) { float t[8];
#pragma unroll
            for (int j = 0; j < 8; ++j) t[j] = a.in[I_CAV][((size_t)(b * 512 + s0 + j) * 16 + h) * 64 + lane];
            w.x = cvt_pk_bf16(t[0], t[1]); w.y = cvt_pk_bf16(t[2], t[3]); w.z = cvt_pk_bf16(t[4], t[5]); w.w = cvt_pk_bf16(t[6], t[7]); }
        *(u32x4*)(VFSA + ((size_t)(bh * 17 + (s0 >> 5)) * 4096 + (lane >> 5) * 2048 + ((s0 & 31) >> 4) * 1024 + (((s0 & 15) >> 3) * 32 + (lane & 31)) * 16)) = w; }
    for (int it = gw; it < 8 * 2 * (SKB / 8); it += NGW) { const int sb = it % (SKB / 8), bh = it / (SKB / 8), b = bh >> 1, h = bh & 1, s0 = sb * 8;
        if (s0 >= 128 && s0 < 144) continue;
        u32x4 w = (u32x4){0u, 0u, 0u, 0u};
        if (s0 < 128) { float t[8];
#pragma unroll
            for (int j = 0; j < 8; ++j) t[j] = a.in[I_CBV][((size_t)(b * 128 + s0 + j) * 2 + h) * 64 + lane];
            w.x = cvt_pk_bf16(t[0], t[1]); w.y = cvt_pk_bf16(t[2], t[3]); w.z = cvt_pk_bf16(t[4], t[5]); w.w = cvt_pk_bf16(t[6], t[7]); }
        *(u32x4*)(VFSB + ((size_t)(bh * 5 + (s0 >> 5)) * 4096 + (lane >> 5) * 2048 + ((s0 & 31) >> 4) * 1024 + (((s0 & 15) >> 3) * 32 + (lane & 31)) * 16)) = w; }
    for (int i = gt; i < MS * DM / 4; i += NGT) ((f32x4*)(a.out + (size_t)MP * DM))[i] = ((const f32x4*)a.in[I_XS])[i];
    float* ssq1 = (float*)(ws + WS_SSQ1); float* ssq2 = (float*)(ws + WS_SSQ2);
    for (int i = gt; i < MPAD; i += NGT) ssq1[i] = 0.f;
    (void)ssq2;
    if (gt == 0) *(unsigned*)(ws + WS_CTL) = 0u;
    for (int i = gt; i < (int)(BAR_BYTES / 4); i += NGT) ((unsigned*)(ws + WS_BAR))[i] = 0u;
}

struct EpiIn {
    static constexpr bool PERM = true, AFTER_DRAIN = false;
    bf16_t *QA, *QB, *KPA, *KSA, *KPB, *KSB, *VTA, *VTSA, *VTB, *VTSB; float* out;
    static __device__ __forceinline__ void rope(f32x4& v0, f32x4& v1, int pos, int fq) {
        float o[8], mine[8] = {v0[0], v0[1], v0[2], v0[3], v1[0], v1[1], v1[2], v1[3]};
#pragma unroll
        for (int j = 0; j < 8; ++j) o[j] = __shfl_xor(mine[j], 16);
        if (fq < 2) {
            const float invf[8] = {1.0f, 0.1939227432012558f, 0.03760603070259094f, 0.007292664609849453f, 0.0014142135623842478f, 0.00027424818836152554f, 5.318296098266728e-05f, 1.0313386155758053e-05f};
            const float sg = (fq == 0) ? -1.f : 1.f;
#pragma unroll
            for (int j = 0; j < 8; ++j) { const float ang = (float)pos * invf[j]; double rev = (double)ang * 0.15915494309189535; rev -= __builtin_rint(rev); const float fr_ = (float)rev;
                const float c = __builtin_amdgcn_cosf(fr_), s = __builtin_amdgcn_sinf(fr_); mine[j] = mine[j] * c + sg * o[j] * s; }
            v0 = (f32x4){mine[0], mine[1], mine[2], mine[3]}; v1 = (f32x4){mine[4], mine[5], mine[6], mine[7]};
        }
    }
    __device__ __forceinline__ void operator()(const f32x4 (&acc)[2][2][4][2], const pg8::Unit& u, int wr, int wc, int fr, int fq) const {
        asm volatile("" : "+v"(fr), "+v"(fq));
        const int pn = u.pn, pm = u.pm; const bool samp = (pm >= 128);
        const int rbase = pm * 256 + wr * 64 + fr, cw = wc * 32 + fq * 8;
        if (pn < 4 || (pn >= 12 && pn < 16)) {
            const bool isB = pn >= 12; bf16_t* Q = isB ? QB : QA; const int c0 = (pn & 3) * 256 + cw; const bool rp = isB && ((wc & 1) == 0);
#pragma unroll
            for (int ai = 0; ai < 2; ++ai)
#pragma unroll
                for (int m = 0; m < 4; ++m) { const int row = rbase + ai * 128 + m * 16; const int pos = samp ? 2048 + (row & 15) : (row & 4095);
#pragma unroll
                    for (int bj = 0; bj < 2; ++bj) { f32x4 v0 = acc[ai][bj][m][0], v1 = acc[ai][bj][m][1];
                        if (rp) rope(v0, v1, pos, fq);
                        const int c = c0 + bj * 128, j = (c & 63) >> 3, lr = row & 63;
                        bf16_t* qd = samp ? Q + (size_t)row * 1024 + c : Q + ((size_t)(row >> 6) * 16 + (c >> 6)) * 4096 + ((lr >> 5) * 4 + (j >> 1)) * 512 + ((j & 1) * 32 + (lr & 31)) * 8;
                        *(u32x4*)qd = pack8(v0 * QSCALE, v1 * QSCALE); } }
        } else if (pn < 12) {
            const bool isV = pn >= 8; const int c0 = (pn - (isV ? 8 : 4)) * 256 + cw;
#pragma unroll
            for (int ai = 0; ai < 2; ++ai) { if (samp && ai == 1) continue;
#pragma unroll
                for (int m = 0; m < 4; ++m) { const int row = rbase + ai * 128 + m * 16; int t, nblk; unsigned char* base; float* od = nullptr;
                    if (!samp) { t = row & 4095; nblk = 128; base = (unsigned char*)(isV ? VTA : KPA) + (size_t)(row >> 12) * 16 * 128 * 4096;
                        if (t >= 3584) od = out + (isV ? O_AVP : O_AKP) + (size_t)((row >> 12) * 512 + t - 3584) * 1024; }
                    else { const int rs = row - MP; t = 512 + (rs & 15); nblk = 17; base = (unsigned char*)(isV ? VTSA : KSA) + (size_t)(rs >> 4) * 16 * 17 * 4096; od = out + (isV ? O_AVS : O_AKS) + (size_t)rs * 1024; }
                    const int toffk = (t >> 5) * 4096 + pi32(t & 31) * 16, toffv = (t >> 5) * 4096 + ((t & 31) >> 4) * 1024 + ((t & 15) >> 3) * 512 + (t & 7) * 2;
#pragma unroll
                    for (int bj = 0; bj < 2; ++bj) { const f32x4 v0 = acc[ai][bj][m][0], v1 = acc[ai][bj][m][1]; const int c = c0 + bj * 128, head = c >> 6, d0 = c & 63;
                        const u32x4 w = pack8(v0, v1); unsigned char* hb = base + (size_t)head * nblk * 4096;
                        if (!isV) { *(u32x4*)(hb + toffk + (d0 >> 4) * 1024 + ((d0 >> 3) & 1) * 512) = w; }
                        else { bf16_t* p = (bf16_t*)(hb + toffv + (d0 >> 5) * 2048 + (d0 & 31) * 16);
                            p[0] = (bf16_t)(w.x & 0xffffu); p[8] = (bf16_t)(w.x >> 16); p[16] = (bf16_t)(w.y & 0xffffu); p[24] = (bf16_t)(w.y >> 16);
                            p[32] = (bf16_t)(w.z & 0xffffu); p[40] = (bf16_t)(w.z >> 16); p[48] = (bf16_t)(w.w & 0xffffu); p[56] = (bf16_t)(w.w >> 16); }
                        if (od) { *(f32x4*)(od + c) = v0; *(f32x4*)(od + c + 4) = v1; } } } }
        } else {
            const bool rp = ((wc & 1) == 0); const int kvh = cw >> 6, d0 = cw & 63;
#pragma unroll
            for (int ai = 0; ai < 2; ++ai) { if (samp && ai == 1) continue;
#pragma unroll
                for (int m = 0; m < 4; ++m) { const int row = rbase + ai * 128 + m * 16;
                    unsigned char* kb_; unsigned char* vb_; float* ok = nullptr; float* ov = nullptr; int pos, t, nblk;
                    if (!samp) { const int b = row >> 12; t = row & 4095; pos = t; nblk = 128; kb_ = (unsigned char*)KPB + (size_t)b * 2 * 128 * 4096; vb_ = (unsigned char*)VTB + (size_t)b * 2 * 128 * 4096;
                        if (t >= 3968) { ok = out + O_BKP + (size_t)(b * 128 + t - 3968) * 128; ov = out + O_BVP + (size_t)(b * 128 + t - 3968) * 128; } }
                    else { const int rs = row - MP, b = rs >> 4; pos = 2048 + (rs & 15); t = 128 + (rs & 15); nblk = 5; kb_ = (unsigned char*)KSB + (size_t)b * 2 * 5 * 4096; vb_ = (unsigned char*)VTSB + (size_t)b * 2 * 5 * 4096;
                        ok = out + O_BKS + (size_t)rs * 128; ov = out + O_BVS + (size_t)rs * 128; }
                    const int toffk = (t >> 5) * 4096 + pi32(t & 31) * 16, toffv = (t >> 5) * 4096 + ((t & 31) >> 4) * 1024 + ((t & 15) >> 3) * 512 + (t & 7) * 2;
                    { f32x4 v0 = acc[ai][0][m][0], v1 = acc[ai][0][m][1];
                        if (rp) rope(v0, v1, pos, fq);
                        *(u32x4*)(kb_ + (size_t)kvh * nblk * 4096 + toffk + (d0 >> 4) * 1024 + ((d0 >> 3) & 1) * 512) = pack8(v0, v1);
                        if (ok) { *(f32x4*)(ok + cw) = v0; *(f32x4*)(ok + cw + 4) = v1; } }
                    { const f32x4 v0 = acc[ai][1][m][0], v1 = acc[ai][1][m][1];
                        const u32x4 w = pack8(v0, v1); bf16_t* p = (bf16_t*)(vb_ + (size_t)kvh * nblk * 4096 + toffv + (d0 >> 5) * 2048 + (d0 & 31) * 16);
                        p[0] = (bf16_t)(w.x & 0xffffu); p[8] = (bf16_t)(w.x >> 16); p[16] = (bf16_t)(w.y & 0xffffu); p[24] = (bf16_t)(w.y >> 16);
                        p[32] = (bf16_t)(w.z & 0xffffu); p[40] = (bf16_t)(w.z >> 16); p[48] = (bf16_t)(w.w & 0xffffu); p[56] = (bf16_t)(w.w >> 16);
                        if (ov) { *(f32x4*)(ov + cw) = v0; *(f32x4*)(ov + cw + 4) = v1; } } } }
        }
    }
};
template <bool FIRST> struct EpiRes {
    static constexpr bool PERM = false, AFTER_DRAIN = false;
    const float* xp; const float* xs; float* out; bf16_t* x1b; float* ssq;
    __device__ __forceinline__ void operator()(const f32x4 (&acc)[2][2][4][2], const pg8::Unit& u, int wr, int wc, int fr, int fq) const {
        asm volatile("" : "+v"(fr), "+v"(fq));
        const int pm = u.pm, col0 = u.pn * 256 + wc * 32 + 4 * fq;
#pragma unroll
        for (int ai = 0; ai < 2; ++ai) { if (pm >= 128 && ai == 1) continue;
            const int row0 = pm * 256 + ai * 128 + wr * 64 + fr;
            f32x4 res[4][2][2];
#pragma unroll
            for (int m = 0; m < 4; ++m) { const int row = row0 + m * 16;
                const float* rrow = FIRST ? ((pm < 128) ? xp + (size_t)row * DM + col0 : xs + (size_t)(row - MP) * DM + col0) : out + (size_t)row * DM + col0;
#pragma unroll
                for (int bj = 0; bj < 2; ++bj)
#pragma unroll
                    for (int n = 0; n < 2; ++n) res[m][bj][n] = *(const f32x4*)(rrow + bj * 128 + n * 16); }
#pragma unroll
            for (int m = 0; m < 4; ++m) { const int row = row0 + m * 16;
                float* orow = out + (size_t)row * DM + col0;
                float ss = 0.f;
#pragma unroll
                for (int bj = 0; bj < 2; ++bj)
#pragma unroll
                    for (int n = 0; n < 2; ++n) { const int c = bj * 128 + n * 16; const f32x4 v = acc[ai][bj][m][n] + res[m][bj][n];
                        if (!FIRST) *(f32x4*)(orow + c) = v;
                        ss += (v[0] * v[0] + v[1] * v[1]) + (v[2] * v[2] + v[3] * v[3]);
                        if (FIRST) { u32x2 w; w.x = cvt_pk_bf16(v[0], v[1]); w.y = cvt_pk_bf16(v[2], v[3]); *(u32x2*)(x1b + (size_t)row * DM + col0 + c) = w; } }
                if (FIRST) { ss += __shfl_xor(ss, 16); ss += __shfl_xor(ss, 32);
                    if (fq == 0) atomicAdd(ssq + row, ss); } } }
    }
};
struct EpiGU {
    static constexpr bool PERM = true, AFTER_DRAIN = false;
    bf16_t* act; const float* ssq1;
    __device__ __forceinline__ void operator()(const f32x4 (&acc)[2][2][4][2], const pg8::Unit& u, int wr, int wc, int fr, int fq) const {
        asm volatile("" : "+v"(fr), "+v"(fq));
        const int pm = u.pm, col0 = u.pn * 128 + wc * 32 + 8 * fq;
        float r1[2][4];
#pragma unroll
        for (int ai = 0; ai < 2; ++ai)
#pragma unroll
            for (int m = 0; m < 4; ++m) r1[ai][m] = (pm >= 128 && ai == 1) ? 0.f : ssq1[pm * 256 + ai * 128 + wr * 64 + m * 16 + fr];
        f32x4 gu[2][4][2];
#pragma unroll
        for (int ai = 0; ai < 2; ++ai)
#pragma unroll
            for (int m = 0; m < 4; ++m)
#pragma unroll
                for (int n = 0; n < 2; ++n) gu[ai][m][n] = acc[ai][0][m][n] * acc[ai][1][m][n];
#pragma unroll
        for (int ai = 0; ai < 2; ++ai)
#pragma unroll
            for (int m = 0; m < 4; ++m) r1[ai][m] = __builtin_amdgcn_rsqf(r1[ai][m] * (1.f / DM) + EPS);
#pragma unroll
        for (int ai = 0; ai < 2; ++ai) { if (pm >= 128 && ai == 1) continue;
#pragma unroll
            for (int m = 0; m < 4; ++m) { const int row = pm * 256 + ai * 128 + wr * 64 + m * 16 + fr;
                const float rr = r1[ai][m], rl = -rr * LOG2E, r2 = rr * rr;
                f32x4 o[2];
#pragma unroll
                for (int n = 0; n < 2; ++n) { const f32x4 g = acc[ai][0][m][n];
#pragma unroll
                    for (int e = 0; e < 4; ++e) o[n][e] = gu[ai][m][n][e] * r2 * __builtin_amdgcn_rcpf(1.0f + __builtin_amdgcn_exp2f(g[e] * rl)); }
                __builtin_nontemporal_store(pack8(o[0], o[1]), (u32x4*)(act + (size_t)row * DFF + col0)); } }
    }
};
struct EpiOut {
    static constexpr bool PERM = true, AFTER_DRAIN = false;
    const bf16_t* xn; const float* xscale; bf16_t* x1b; float* ssq;
    __device__ __forceinline__ void operator()(const f32x4 (&acc)[2][2][4][2], const pg8::Unit& u, int wr, int wc, int fr, int fq) const {
        asm volatile("" : "+v"(fr), "+v"(fq));
        const int row0 = u.pm * 256 + wr * 64 + fr; const size_t off0 = (size_t)row0 * DM + u.pn * 256 + wc * 32 + 8 * fq;
        u32x4 res[2][4][2]; float sc[2][4];
#pragma unroll
        for (int ai = 0; ai < 2; ++ai)
#pragma unroll
            for (int m = 0; m < 4; ++m) { sc[ai][m] = xscale[row0 + ai * 128 + m * 16];
#pragma unroll
                for (int bj = 0; bj < 2; ++bj) res[ai][m][bj] = *(const u32x4*)(xn + off0 + (size_t)(ai * 128 + m * 16) * DM + bj * 128); }
#pragma unroll
        for (int ai = 0; ai < 2; ++ai)
#pragma unroll
            for (int m = 0; m < 4; ++m) { float ss = 0.f; const float q = sc[ai][m];
#pragma unroll
                for (int bj = 0; bj < 2; ++bj) { const u32x4 w = res[ai][m][bj]; const f32x4 a0 = acc[ai][bj][m][0], a1 = acc[ai][bj][m][1];
                    const f32x4 v0 = (f32x4){__uint_as_float(w.x << 16), __uint_as_float(w.x & 0xffff0000u), __uint_as_float(w.y << 16), __uint_as_float(w.y & 0xffff0000u)} * q + a0;
                    const f32x4 v1 = (f32x4){__uint_as_float(w.z << 16), __uint_as_float(w.z & 0xffff0000u), __uint_as_float(w.w << 16), __uint_as_float(w.w & 0xffff0000u)} * q + a1;
                    ss += ((v0[0] * v0[0] + v0[1] * v0[1]) + (v0[2] * v0[2] + v0[3] * v0[3])) + ((v1[0] * v1[0] + v1[1] * v1[1]) + (v1[2] * v1[2] + v1[3] * v1[3]));
                    *(u32x4*)(x1b + off0 + (size_t)(ai * 128 + m * 16) * DM + bj * 128) = pack8(v0, v1); }
                ss += __shfl_xor(ss, 16); ss += __shfl_xor(ss, 32);
                if (fq == 0) atomicAdd(ssq + row0 + ai * 128 + m * 16, ss); }
    }
};
struct EpiDown {
    static constexpr bool PERM = true, AFTER_DRAIN = false;
    bf16_t* x;
    __device__ __forceinline__ void operator()(const f32x4 (&acc)[2][2][4][2], const pg8::Unit& u, int wr, int wc, int fr, int fq) const {
        asm volatile("" : "+v"(fr), "+v"(fq));
        bf16_t* base = x + (size_t)(u.pm * 256 + wr * 64 + fr) * DM + u.pn * 256 + wc * 32 + 8 * fq;
        u32x4 res[2][4][2];
#pragma unroll
        for (int ai = 0; ai < 2; ++ai)
#pragma unroll
            for (int m = 0; m < 4; ++m)
#pragma unroll
                for (int bj = 0; bj < 2; ++bj) res[ai][m][bj] = *(const u32x4*)(base + (size_t)(ai * 128 + m * 16) * DM + bj * 128);
#pragma unroll
        for (int ai = 0; ai < 2; ++ai)
#pragma unroll
            for (int m = 0; m < 4; ++m)
#pragma unroll
                for (int bj = 0; bj < 2; ++bj) { const u32x4 w = res[ai][m][bj]; const f32x4 a0 = acc[ai][bj][m][0], a1 = acc[ai][bj][m][1]; u32x4 o;
                    o.x = cvt_pk_bf16(__uint_as_float(w.x << 16) + a0[0], __uint_as_float(w.x & 0xffff0000u) + a0[1]);
                    o.y = cvt_pk_bf16(__uint_as_float(w.y << 16) + a0[2], __uint_as_float(w.y & 0xffff0000u) + a0[3]);
                    o.z = cvt_pk_bf16(__uint_as_float(w.z << 16) + a1[0], __uint_as_float(w.z & 0xffff0000u) + a1[1]);
                    o.w = cvt_pk_bf16(__uint_as_float(w.w << 16) + a1[2], __uint_as_float(w.w & 0xffff0000u) + a1[3]);
                    *(u32x4*)(base + (size_t)(ai * 128 + m * 16) * DM + bj * 128) = o; }
    }
};
struct SplitKOrder {
    int pm, npn, nks, kl, G, c;
    __device__ __forceinline__ bool next(int i, pg8::Unit& u) const { const int L = i * G + c; if (L >= npn * nks) return false; u.pm = pm; u.pn = L / nks; u.k0 = (L % nks) * kl; return true; }
    __device__ __forceinline__ void a_ready(const pg8::Unit&) const {}
    __device__ __forceinline__ void done(const pg8::Unit&) const {}
};
struct EpiAtomic {
    static constexpr bool PERM = false, AFTER_DRAIN = false;
    float* out;
    __device__ __forceinline__ void operator()(const f32x4 (&acc)[2][2][4][2], const pg8::Unit& u, int wr, int wc, int fr, int fq) const {
        asm volatile("" : "+v"(fr), "+v"(fq));
        const int pm = u.pm, col0 = u.pn * 256 + wc * 32 + 4 * fq;
#pragma unroll
        for (int ai = 0; ai < 2; ++ai) { if (pm >= 128 && ai == 1) continue;
#pragma unroll
            for (int m = 0; m < 4; ++m) { float* orow = out + (size_t)(pm * 256 + ai * 128 + wr * 64 + m * 16 + fr) * DM + col0;
#pragma unroll
                for (int bj = 0; bj < 2; ++bj)
#pragma unroll
                    for (int n = 0; n < 2; ++n)
#pragma unroll
                        for (int e = 0; e < 4; ++e) __hip_atomic_fetch_add(orow + bj * 128 + n * 16 + e, acc[ai][bj][m][n][e], __ATOMIC_RELAXED, __HIP_MEMORY_SCOPE_AGENT); } }
    }
};

__device__ __forceinline__ float swapmax(float m) { auto rr = __builtin_amdgcn_permlane32_swap(__float_as_uint(m), __float_as_uint(m), false, false); return fmaxf(__uint_as_float(rr[0]), __uint_as_float(rr[1])); }
__device__ __forceinline__ float swapsum(float m) { auto rr = __builtin_amdgcn_permlane32_swap(__float_as_uint(m), __float_as_uint(m), false, false); return __uint_as_float(rr[0]) + __uint_as_float(rr[1]); }
#define MFMA32(a, b, c) __builtin_amdgcn_mfma_f32_32x32x16_bf16((a), (b), (c), 0, 0, 0)
__device__ __forceinline__ void attn_head(const bf16_t* __restrict__ Qp, const unsigned char* __restrict__ Kt, const unsigned char* __restrict__ Vt, int nkeys, int relbase,
                                          const LAS float* btab, float m_init, float l_init, LAS unsigned char* otile, int ocol, float& ssq0, float& ssq1, int lane, bool qfrag) {
    const int r32 = lane & 31, hi = lane >> 5;
    bf16x8 qf[2][4];
#pragma unroll
    for (int qb = 0; qb < 2; ++qb)
#pragma unroll
        for (int d0 = 0; d0 < 4; ++d0) qf[qb][d0] = qfrag ? *(const bf16x8*)(Qp + (qb * 4 + d0) * 512 + lane * 8) : *(const bf16x8*)(Qp + (size_t)(qb * 32 + r32) * 1024 + d0 * 16 + hi * 8);
    f32x16 o[2][2];
#pragma unroll
    for (int qb = 0; qb < 2; ++qb)
#pragma unroll
        for (int db = 0; db < 2; ++db)
#pragma unroll
            for (int r = 0; r < 16; ++r) o[qb][db][r] = 0.f;
    float mref[2] = {m_init, m_init}, lrun[2] = {hi == 0 ? l_init : 0.f, hi == 0 ? l_init : 0.f};
    const unsigned char* kbase = Kt + lane * 16;
    const unsigned char* vbase = Vt + lane * 16;
    const int nblk = (nkeys + 31) >> 5;
    const float cfar = btab ? btab[256] : 0.f;
    bf16x8 kf[4], vf[2][2], kn[4], vn[2][2];
#pragma unroll
    for (int d0 = 0; d0 < 4; ++d0) kf[d0] = *(const bf16x8*)(kbase + d0 * 1024);
#pragma unroll
    for (int db = 0; db < 2; ++db)
#pragma unroll
        for (int ks = 0; ks < 2; ++ks) vf[db][ks] = *(const bf16x8*)(vbase + db * 2048 + ks * 1024);
    for (int kb = 0; kb < nblk; ++kb) {
        if (kb + 1 < nblk) {
            const unsigned char* kp = kbase + (size_t)(kb + 1) * 4096; const unsigned char* vp = vbase + (size_t)(kb + 1) * 4096;
#pragma unroll
            for (int d0 = 0; d0 < 4; ++d0) kn[d0] = *(const bf16x8*)(kp + d0 * 1024);
#pragma unroll
            for (int db = 0; db < 2; ++db)
#pragma unroll
                for (int ks = 0; ks < 2; ++ks) vn[db][ks] = *(const bf16x8*)(vp + db * 2048 + ks * 1024);
        }
        const int kb0 = kb * 32 + 8 * hi;
        const bool tail = (kb * 32 + 32 > nkeys);
        const bool far = (relbase - (kb * 32 + 31) >= 128);
#pragma unroll
        for (int qb = 0; qb < 2; ++qb) {
            const float sinit = ((btab && far) ? cfar : 0.f) - mref[qb];
            f32x16 s;
#pragma unroll
            for (int r = 0; r < 16; ++r) s[r] = sinit;
#pragma unroll
            for (int d0 = 0; d0 < 4; ++d0) s = MFMA32(kf[d0], qf[qb][d0], s);
            if (btab && !far) { const LAS float* bp = btab + (relbase + qb * 32 + r32 - kb0 + 128);
#pragma unroll
                for (int r = 0; r < 16; ++r) s[r] += bp[-(16 * (r >> 3) + (r & 7))];
            }
            if (tail) {
#pragma unroll
                for (int r = 0; r < 16; ++r) if (kb0 + 16 * (r >> 3) + (r & 7) >= nkeys) s[r] = -1e30f;
            }
            float m0 = fmaxf(fmaxf(s[0], s[1]), s[2]), m1 = fmaxf(fmaxf(s[3], s[4]), s[5]);
            m0 = fmaxf(fmaxf(m0, s[6]), s[7]); m1 = fmaxf(fmaxf(m1, s[8]), s[9]); m0 = fmaxf(fmaxf(m0, s[10]), s[11]); m1 = fmaxf(fmaxf(m1, s[12]), s[13]); m0 = fmaxf(fmaxf(m0, s[14]), s[15]);
            const float mx = swapmax(fmaxf(m0, m1));
            if (btab && kb == 0) {
                mref[qb] = mx;
#pragma unroll
                for (int r = 0; r < 16; ++r) s[r] -= mx;
            } else if (__builtin_amdgcn_ballot_w64(mx > 8.0f) != 0ull) {
                const float dl = fmaxf(mx, 0.f), alpha = __builtin_amdgcn_exp2f(-dl);
                mref[qb] += dl; lrun[qb] *= alpha;
#pragma unroll
                for (int r = 0; r < 16; ++r) s[r] -= dl;
#pragma unroll
                for (int db = 0; db < 2; ++db)
#pragma unroll
                    for (int r = 0; r < 16; ++r) o[qb][db][r] *= alpha;
            }
            float ps0 = 0.f, ps1 = 0.f;
#pragma unroll
            for (int r = 0; r < 16; r += 2) { s[r] = __builtin_amdgcn_exp2f(s[r]); s[r + 1] = __builtin_amdgcn_exp2f(s[r + 1]); ps0 += s[r]; ps1 += s[r + 1]; }
            lrun[qb] += ps0 + ps1;
            u32x4 p0, p1;
            p0.x = cvt_pk_bf16(s[0], s[1]); p0.y = cvt_pk_bf16(s[2], s[3]); p0.z = cvt_pk_bf16(s[4], s[5]); p0.w = cvt_pk_bf16(s[6], s[7]);
            p1.x = cvt_pk_bf16(s[8], s[9]); p1.y = cvt_pk_bf16(s[10], s[11]); p1.z = cvt_pk_bf16(s[12], s[13]); p1.w = cvt_pk_bf16(s[14], s[15]);
            const bf16x8 pf0 = __builtin_bit_cast(bf16x8, p0), pf1 = __builtin_bit_cast(bf16x8, p1);
#pragma unroll
            for (int db = 0; db < 2; ++db) {
                o[qb][db] = MFMA32(vf[db][0], pf0, o[qb][db]);
                o[qb][db] = MFMA32(vf[db][1], pf1, o[qb][db]);
            }
        }
#pragma unroll
        for (int d0 = 0; d0 < 4; ++d0) kf[d0] = kn[d0];
#pragma unroll
        for (int db = 0; db < 2; ++db)
#pragma unroll
            for (int ks = 0; ks < 2; ++ks) vf[db][ks] = vn[db][ks];
    }
#pragma unroll
    for (int qb = 0; qb < 2; ++qb) {
        const float inv = 1.0f / swapsum(lrun[qb]); float ss = 0.f;
        LAS unsigned char* rowp = otile + (qb * 32 + r32) * OT_STRIDE + (ocol + 4 * hi) * 2;
#pragma unroll
        for (int db = 0; db < 2; ++db)
#pragma unroll
            for (int g = 0; g < 4; ++g) { const float v0 = o[qb][db][4 * g] * inv, v1 = o[qb][db][4 * g + 1] * inv, v2 = o[qb][db][4 * g + 2] * inv, v3 = o[qb][db][4 * g + 3] * inv;
                ss += (v0 * v0 + v1 * v1) + (v2 * v2 + v3 * v3);
                u32x2 w; w.x = cvt_pk_bf16(v0, v1); w.y = cvt_pk_bf16(v2, v3);
                *(LAS u32x2*)(rowp + (db * 32 + 8 * g) * 2) = w; }
        ss = swapsum(ss);
        if (qb == 0) ssq0 += ss; else ssq1 += ss;
    }
}

constexpr int N_ATT_UNITS = 512 + 8 + 512 + 8;
__device__ __forceinline__ void attn_phase(const Args& a, LAS unsigned char* lds, int tid, int wave, int lane) {
    unsigned char* ws = a.ws;
    const bf16_t* QA = (const bf16_t*)(ws + WS_QA); const bf16_t* QB = (const bf16_t*)(ws + WS_QB); const bf16_t* KPA = (const bf16_t*)(ws + WS_KPA); const bf16_t* KPB = (const bf16_t*)(ws + WS_KPB);
    const bf16_t* KSA = (const bf16_t*)(ws + WS_KSA); const bf16_t* KSB = (const bf16_t*)(ws + WS_KSB); const bf16_t* VTA = (const bf16_t*)(ws + WS_VTA); const bf16_t* VTB = (const bf16_t*)(ws + WS_VTB);
    const bf16_t* VTSA = (const bf16_t*)(ws + WS_VTSA); const bf16_t* VTSB = (const bf16_t*)(ws + WS_VTSB);
    bf16_t* O = (bf16_t*)(ws + WS_O);
    unsigned* counter = (unsigned*)(ws + WS_CTL);
    LAS unsigned* lctl = (LAS unsigned*)(lds + L_CTL);
    LAS float* lssq = (LAS float*)(lds + L_SSQ);
    LAS float* btab = (LAS float*)(lds + L_BIAS + wave * 1408);
    LAS unsigned char* otile = lds + L_OT;
    for (;;) {
        if (tid == 0) lctl[0] = atomicAdd(counter, 1u);
        __syncthreads();
        const int u = (int)lctl[0];
        if (u >= N_ATT_UNITS) break;
        int grp, b, c = 0; bool samp;
        if (u < 512) { grp = 0; samp = false; b = u >> 6; c = 63 - (u & 63); }
        else if (u < 520) { grp = 0; samp = true; b = u - 512; }
        else if (u < 1032) { grp = 1; samp = false; b = (u - 520) >> 6; c = 63 - ((u - 520) & 63); }
        else { grp = 1; samp = true; b = u - 1032; }
        float ssq0 = 0.f, ssq1 = 0.f;
        for (int hh = 0; hh < 2; ++hh) {
            const int head = 2 * wave + hh;
            const bf16_t* Qp; const unsigned char *Kt, *Vt; int nkeys, relbase; const LAS float* bt; float mi, li;
            if (grp == 0) {
                for (int i = lane; i < 352; i += 64) btab[i] = a.in[I_REL][head * 257 + min(i, 256)] * LOG2E;
                bt = btab; mi = 0.f; li = 0.f;
                if (!samp) { const int c0 = max(c - 8, 0); const size_t to = ((size_t)(b * 16 + head) * 128 + 2 * c0) * 4096;
                    Qp = QA + ((size_t)(b * 64 + c) * 16 + head) * 4096; Kt = (const unsigned char*)KPA + to; Vt = (const unsigned char*)VTA + to; nkeys = (c - c0 + 1) * 64; relbase = (c - c0) * 64;
                } else { const size_t to = (size_t)(b * 16 + head) * 17 * 4096;
                    Qp = QA + (size_t)(MP + b * 16) * 1024 + head * 64; Kt = (const unsigned char*)KSA + to; Vt = (const unsigned char*)VTSA + to; nkeys = 528; relbase = 512;
                }
            } else {
                const int kvh = head >> 3; bt = nullptr; mi = a.in[I_SINK][head] * LOG2E; li = 1.f; relbase = 0;
                if (!samp) { const int c0 = max(c - 2, 0); const size_t to = ((size_t)(b * 2 + kvh) * 128 + 2 * c0) * 4096;
                    Qp = QB + ((size_t)(b * 64 + c) * 16 + head) * 4096; Kt = (const unsigned char*)KPB + to; Vt = (const unsigned char*)VTB + to; nkeys = (c - c0 + 1) * 64;
                } else { const size_t to = (size_t)(b * 2 + kvh) * 5 * 4096;
                    Qp = QB + (size_t)(MP + b * 16) * 1024 + head * 64; Kt = (const unsigned char*)KSB + to; Vt = (const unsigned char*)VTSB + to; nkeys = 144;
                }
            }
            attn_head(Qp, Kt, Vt, nkeys, relbase, bt, mi, li, otile, head * 64, ssq0, ssq1, lane, !samp);
        }
        if (lane < 32) { lssq[wave * 64 + lane] = ssq0; lssq[wave * 64 + 32 + lane] = ssq1; }
        __syncthreads();
        const int nvalid = samp ? 16 : 64; const size_t grow0 = samp ? (size_t)(MP + b * 16) : (size_t)(b * 4096 + c * 64);
        for (int i = 0; i < 8; ++i) { const int row = wave * 8 + i; if (row >= nvalid) break;
            float t = 0.f;
#pragma unroll
            for (int w = 0; w < 8; ++w) t += lssq[w * 64 + row];
            const float rn = 1.0f / sqrtf(t * (1.f / 1024.f) + EPS);
#pragma unroll
            for (int j = 0; j < 2; ++j) { const int ch = lane + 64 * j; const u32x4 w = *(const LAS u32x4*)(otile + row * OT_STRIDE + ch * 16); u32x4 r;
#pragma unroll
                for (int e = 0; e < 4; ++e) { const float lo = __uint_as_float(w[e] << 16) * rn, hi_ = __uint_as_float(w[e] & 0xffff0000u) * rn; r[e] = cvt_pk_bf16(lo, hi_); }
                *(u32x4*)(O + (grow0 + row) * DM + grp * 1024 + ch * 8) = r; } }
        __syncthreads();
    }
}

#define XB_TMO      128
#define XB_XCNT(j)  (256  + 64 * (j))
#define XB_XSUB(j)  (1280 + 64 * (j))
#define XB_XGEN(j)  (2304 + 64 * (j))
#define XB_TOP      3328
#define XB_TOPGEN   3392
#define XCD_BAR_WORDS 3456
#define XB_SPIN_CAP (1u << 18)

__device__ __forceinline__ unsigned xb_ld(unsigned* p)              { return __hip_atomic_load(p, __ATOMIC_RELAXED, __HIP_MEMORY_SCOPE_AGENT); }
__device__ __forceinline__ unsigned xb_add(unsigned* p, unsigned v) { return __hip_atomic_fetch_add(p, v, __ATOMIC_RELAXED, __HIP_MEMORY_SCOPE_AGENT); }
__device__ __forceinline__ unsigned xb_xcc_id() { return (unsigned)__builtin_amdgcn_s_getreg((3 << 11) | 20) & 0xFu; }
#define XB_SPIN(cond, bar) do { unsigned _sp = 0; while (cond) { __builtin_amdgcn_s_sleep(1); \
    if ((++_sp & 255u) == 0u) { if (xb_ld(&(bar)[XB_TMO])) break; if (_sp > XB_SPIN_CAP) { atomicAdd(&(bar)[XB_TMO], 1u); break; } } } } while (0)

struct XcdBarrier {
    unsigned* bar; unsigned x;
    volatile LAS unsigned* st;
};

__device__ __forceinline__ XcdBarrier xcd_barrier_post(unsigned* bar, volatile LAS unsigned* st) {
    XcdBarrier b; b.bar = bar; b.x = xb_xcc_id(); b.st = st;
    if (threadIdx.x == 0) (void)xb_add(&bar[XB_XCNT(b.x)], 1u);
    return b;
}
__device__ __forceinline__ void xcd_barrier_complete(unsigned* bar, unsigned x, unsigned& nloc, unsigned& nx) {
    const unsigned G = gridDim.x * gridDim.y * gridDim.z;
    unsigned sum, cnt, mine, sp = 0u;
    for (;;) {
        sum = 0u; cnt = 0u; mine = 0u;
#pragma unroll
        for (unsigned j = 0; j < 16; ++j) { const unsigned c = xb_ld(&bar[XB_XCNT(j)]); sum += c; cnt += (c > 0u) ? 1u : 0u; mine = (j == x) ? c : mine; }
        if (sum == G) break;
        __builtin_amdgcn_s_sleep(1);
        if ((++sp & 255u) == 0u) { if (xb_ld(&bar[XB_TMO])) break; if (sp > XB_SPIN_CAP) { atomicAdd(&bar[XB_TMO], 1u); break; } }
    }
    nloc = mine > 0u ? mine : 1u; nx = cnt > 0u ? cnt : 1u;
}

__device__ __forceinline__ void xcd_barrier(const XcdBarrier& b) {
    asm volatile("s_waitcnt vmcnt(0)" ::: "memory");
    __syncthreads();
    if (threadIdx.x == 0) {
        unsigned* bar = b.bar;
        __builtin_amdgcn_s_waitcnt(0);
        unsigned nloc = b.st[0], nx = b.st[1];
        if (nloc == 0u) { xcd_barrier_complete(bar, b.x, nloc, nx); b.st[0] = nloc; b.st[1] = nx; }
        const unsigned old = xb_add(&bar[XB_XSUB(b.x)], 1u);
        const unsigned gen = old / nloc;
        if (old + 1u == (gen + 1u) * nloc) {
            __builtin_amdgcn_fence(__ATOMIC_RELEASE, "agent");
            asm volatile("s_waitcnt vmcnt(0)" ::: "memory");
            const unsigned og = xb_add(&bar[XB_TOP], 1u);
            const unsigned tg = og / nx;
            if (og + 1u == (tg + 1u) * nx) xb_add(&bar[XB_TOPGEN], 1u);
            else XB_SPIN(xb_ld(&bar[XB_TOPGEN]) == tg, bar);
            __builtin_amdgcn_fence(__ATOMIC_ACQUIRE, "agent");
            xb_add(&bar[XB_XGEN(b.x)], 1u);
            asm volatile("s_waitcnt vmcnt(0)" ::: "memory");
        } else {
            XB_SPIN(xb_ld(&bar[XB_XGEN(b.x)]) == gen, bar);
            __builtin_amdgcn_fence(__ATOMIC_ACQUIRE, "agent");
            asm volatile("s_waitcnt vmcnt(0)" ::: "memory");
        }
    }
    __syncthreads();
}

__global__ void __launch_bounds__(512, 2) hymba_fwd(Args a) {
    extern __shared__ __attribute__((aligned(16))) unsigned char lds_raw[];
    cg::grid_group grid = cg::this_grid();
    LAS unsigned char* lds = (LAS unsigned char*)lds_raw;
    const int tid = threadIdx.x, lane = tid & 63, wave = __builtin_amdgcn_readfirstlane(tid >> 6);
    const int G = gridDim.x, bx = blockIdx.x;
    unsigned char* ws = a.ws;
    float* ssq1 = (float*)(ws + WS_SSQ1); float* ssq2 = (float*)(ws + WS_SSQ2);
    if (tid < 16) ((LAS unsigned*)(lds + L_CTL))[tid] = 0u;
    __syncthreads();
    bf16_t* XN = (bf16_t*)(ws + WS_XN); bf16_t* O = (bf16_t*)(ws + WS_O); bf16_t* X1B = (bf16_t*)(ws + WS_X1B); bf16_t* ACT = (bf16_t*)(ws + WS_ACT);

#ifndef NO_P0
    p0_prologue(a, lds, bx, G, wave, lane);
#endif
    grid.sync();
    const XcdBarrier bar = xcd_barrier_post((unsigned*)(ws + WS_BAR), (volatile LAS unsigned*)(lds + L_CTL) + 8);
#ifndef NO_P1
    {
        pg8::Gemm g{XN, (const bf16_t*)(ws + WS_WIN), MPAD, DIN, DM, DM}; pg8::StaticOrder S; S.init(MPAD, DIN, G, bx);
        EpiIn E{(bf16_t*)(ws + WS_QA), (bf16_t*)(ws + WS_QB), (bf16_t*)(ws + WS_KPA), (bf16_t*)(ws + WS_KSA), (bf16_t*)(ws + WS_KPB), (bf16_t*)(ws + WS_KSB),
                (bf16_t*)(ws + WS_VTA), (bf16_t*)(ws + WS_VTSA), (bf16_t*)(ws + WS_VTB), (bf16_t*)(ws + WS_VTSB), a.out};
        pg8::gemm_phase<EpiIn, pg8::StaticOrder, true, true>(lds, g, S, E);
    }
#endif
    xcd_barrier(bar);
#ifndef NO_P2
    { int t2 = threadIdx.x; asm volatile("" : "+v"(t2)); attn_phase(a, lds, t2, __builtin_amdgcn_readfirstlane(t2 >> 6), t2 & 63); }
#endif
    xcd_barrier(bar);
#ifndef NO_P3
    {
        pg8::Gemm g{O, (const bf16_t*)(ws + WS_WOUT), MP, DM, DM, DM}; pg8::StaticOrder S; S.init(MP, DM, G, bx);
        EpiOut E{XN, (const float*)(ws + WS_SSQ2), X1B, ssq1};
        pg8::gemm_phase<EpiOut, pg8::StaticOrder, true, true>(lds, g, S, E);
        pg8::Gemm g2{O, (const bf16_t*)(ws + WS_WOUT), MPAD, DM, DM, 256}; SplitKOrder S2{128, DM / 256, DM / 256, 256, G, bx};
        EpiAtomic E2{a.out};
        pg8::gemm_phase<EpiAtomic, SplitKOrder, true, true>(lds, g2, S2, E2);
    }
#endif
    xcd_barrier(bar);
#ifndef NO_P4
    {
        if (bx < NGU / 256) {
            for (int i = 0; i < 16; ++i) { const int m = MP + wave * 16 + i; const f32x4* xr = (const f32x4*)(a.out + (size_t)m * DM) + lane; f32x4 v[8]; float s = 0.f;
#pragma unroll
                for (int j = 0; j < 8; ++j) { v[j] = xr[64 * j]; s += (v[j].x * v[j].x + v[j].y * v[j].y) + (v[j].z * v[j].z + v[j].w * v[j].w); }
                s = wave_sum(s); if (lane == 0) ssq1[m] = s;
                u32x2* o8 = (u32x2*)(X1B + (size_t)m * DM) + lane;
#pragma unroll
                for (int j = 0; j < 8; ++j) { u32x2 w; w.x = cvt_pk_bf16(v[j].x, v[j].y); w.y = cvt_pk_bf16(v[j].z, v[j].w); o8[64 * j] = w; } }
            asm volatile("s_waitcnt vmcnt(0)" ::: "memory"); __syncthreads();
        }
        pg8::Gemm g{X1B, (const bf16_t*)(ws + WS_WGU), MP, NGU, DM, DM}; pg8::StaticOrder S; S.init(MP, NGU, G, bx);
        EpiGU E{ACT, ssq1};
        pg8::gemm_phase<EpiGU, pg8::StaticOrder, true, true>(lds, g, S, E);
        SplitKOrder S2{128, NGU / 256, 1, 0, G, bx};
        pg8::gemm_phase<EpiGU, SplitKOrder, true, true, true>(lds, g, S2, E);
    }
#endif
    xcd_barrier(bar);
#ifndef NO_P5
    {
        pg8::Gemm g{ACT, (const bf16_t*)(ws + WS_WD), MP, DM, DFF, DFF}; pg8::StaticOrder S; S.init(MP, DM, G, bx);
        EpiDown E{X1B};
        pg8::gemm_phase<EpiDown, pg8::StaticOrder, true, true>(lds, g, S, E);
        pg8::Gemm g2{ACT, (const bf16_t*)(ws + WS_WD), MPAD, DM, DFF, 256}; SplitKOrder S2{128, DM / 256, DFF / 256, 256, G, bx};
        EpiAtomic E2{a.out};
        pg8::gemm_phase<EpiAtomic, SplitKOrder, true, true>(lds, g2, S2, E2);
    }
#endif
    xcd_barrier(bar);
    {
        const float* gf = a.in[I_NFIN];
        const int gw = bx * 8 + wave, NGW = G * 8;
        for (int m0 = gw; m0 < MP; m0 += 4 * NGW) {
            u32x4 w[4][4];
#pragma unroll
            for (int rr = 0; rr < 4; ++rr) { const int m = min(m0 + rr * NGW, MP - 1); const u32x4* xr = (const u32x4*)(X1B + (size_t)m * DM) + lane;
#pragma unroll
                for (int j = 0; j < 4; ++j) w[rr][j] = xr[64 * j]; }
#pragma unroll
            for (int rr = 0; rr < 4; ++rr) { const int m = m0 + rr * NGW; if (m >= MP) break;
                f32x4 v[4][2]; float s = 0.f;
#pragma unroll
                for (int j = 0; j < 4; ++j) { v[j][0] = (f32x4){__uint_as_float(w[rr][j].x << 16), __uint_as_float(w[rr][j].x & 0xffff0000u), __uint_as_float(w[rr][j].y << 16), __uint_as_float(w[rr][j].y & 0xffff0000u)};
                    v[j][1] = (f32x4){__uint_as_float(w[rr][j].z << 16), __uint_as_float(w[rr][j].z & 0xffff0000u), __uint_as_float(w[rr][j].w << 16), __uint_as_float(w[rr][j].w & 0xffff0000u)};
#pragma unroll
                    for (int h = 0; h < 2; ++h) s += (v[j][h].x * v[j][h].x + v[j][h].y * v[j][h].y) + (v[j][h].z * v[j][h].z + v[j][h].w * v[j][h].w); }
                const float r = __builtin_amdgcn_rsqf(wave_sum(s) * (1.f / DM) + EPS);
                f32x4* yo = (f32x4*)(a.out + (size_t)m * DM);
#pragma unroll
                for (int j = 0; j < 4; ++j)
#pragma unroll
                    for (int h = 0; h < 2; ++h) { const int q = 2 * (lane + 64 * j) + h; yo[q] = v[j][h] * r * ((const f32x4*)gf)[q]; } }
        }
        for (int m = MP + gw; m < MV; m += NGW) {
            f32x4* xr = (f32x4*)(a.out + (size_t)m * DM) + lane; f32x4 v[8]; float s = 0.f;
#pragma unroll
            for (int j = 0; j < 8; ++j) { v[j] = xr[64 * j]; s += (v[j].x * v[j].x + v[j].y * v[j].y) + (v[j].z * v[j].z + v[j].w * v[j].w); }
            const float r = 1.0f / sqrtf(wave_sum(s) * (1.f / DM) + EPS);
#pragma unroll
            for (int j = 0; j < 8; ++j) { const f32x4 gv = ((const f32x4*)gf)[lane + 64 * j]; xr[64 * j] = v[j] * r * gv; }
        }
    }
}

extern "C" void kernel_launch(void* const* d_in, const int* in_sizes, int n_in, void* d_out, int out_size, void* d_ws, size_t ws_size, hipStream_t stream) {
    static int grid = 0;
    if (grid == 0) {
        if (n_in != 18 || in_sizes[0] != MP * DM || (size_t)out_size != O_END || ws_size < WS_END) {
            fprintf(stderr, "kernel_launch: unexpected shapes: n_in %d in0 %d out %d ws %zu\n", n_in, n_in > 0 ? in_sizes[0] : -1, out_size, ws_size); grid = -1; return; }
        int dev = 0, cus = 0, per_cu = 0;
        (void)hipGetDevice(&dev); (void)hipDeviceGetAttribute(&cus, hipDeviceAttributeMultiprocessorCount, dev);
        if (hipFuncSetAttribute((const void*)hymba_fwd, hipFuncAttributeMaxDynamicSharedMemorySize, LDS_BYTES) != hipSuccess) { fprintf(stderr, "kernel_launch: hipFuncSetAttribute failed\n"); }
        if (hipOccupancyMaxActiveBlocksPerMultiprocessor(&per_cu, (const void*)hymba_fwd, 512, LDS_BYTES) != hipSuccess || per_cu < 1) { fprintf(stderr, "kernel_launch: occupancy query says %d\n", per_cu); per_cu = 1; }
        (void)hipGetLastError();
        grid = cus * per_cu;
    }
    if (grid < 0) return;
    Args a{};
    for (int i = 0; i < 18; ++i) a.in[i] = (const float*)d_in[i];
    a.out = (float*)d_out; a.ws = (unsigned char*)d_ws;
    void* args[] = {&a};
    hipError_t e = hipLaunchCooperativeKernel((const void*)hymba_fwd, dim3(grid), dim3(512), args, LDS_BYTES, stream);
    if (e != hipSuccess) fprintf(stderr, "cooperative launch failed: %s (grid %d)\n", hipGetErrorString(e), grid);
}
```
